# Optimizing an MI355X kernel written in HIP

```python
import math
import jax, jax.numpy as jnp
from jax import lax
import numpy as np

D_MODEL = 1024
BATCH = 2
SEQ = 8192
DEPTH = 4

POOL_WINDOWS = (2, 4, 8, 16)
POOL_GROUP = D_MODEL // 8
POOL_WIDTH = POOL_GROUP * len(POOL_WINDOWS)
SSM_D_INNER = D_MODEL
SSM_HEAD_DIM = 64
SSM_HEADS = SSM_D_INNER // SSM_HEAD_DIM
SSM_GROUPS = 2
SSM_STATE = 128
SSM_CONV = 4
SSM_CHUNK = 128
SSM_CONV_DIM = SSM_D_INNER + 2 * SSM_GROUPS * SSM_STATE
EVEN_IN = POOL_WIDTH + SSM_D_INNER + SSM_CONV_DIM + SSM_HEADS
EVEN_MIX = POOL_WIDTH + SSM_D_INNER
FOX_HEADS = 8
FOX_HEAD_DIM = 64
FOX_WIDTH = FOX_HEADS * FOX_HEAD_DIM
MLA_HEADS = 8
MLA_NOPE = 64
MLA_ROPE = 32
MLA_V = 64
MLA_Q_RANK = 512
MLA_KV_RANK = 256
ROPE_THETA = 10000.0
ODD_IN = 3 * FOX_WIDTH + FOX_HEADS + MLA_Q_RANK + MLA_KV_RANK + MLA_ROPE
ODD_MIX = FOX_WIDTH + MLA_HEADS * MLA_V
ATTN_BLOCK = 128
D_FF = -(-8 * D_MODEL // (3 * 256)) * 256
DEEPNORM_ALPHA = (2 * DEPTH) ** 0.25
DEEPNORM_BETA = (8 * DEPTH) ** -0.25
N_EVEN = (DEPTH + 1) // 2
N_ODD = DEPTH // 2
LN_EPS = 1e-5
RMS_EPS = 1e-6

kernel_name = "hybrid_pool_ssd_fox_mla_deepnorm"

F32 = jnp.float32


def layer_norm(x, g, b):
    xf = x.astype(F32)
    mu = jnp.mean(xf, axis=-1, keepdims=True)
    var = jnp.mean(jnp.square(xf - mu), axis=-1, keepdims=True)
    return ((xf - mu) * lax.rsqrt(var + LN_EPS) * g + b).astype(x.dtype)


def rms_norm(x, g):
    xf = x.astype(F32)
    return (xf * lax.rsqrt(jnp.mean(jnp.square(xf), axis=-1, keepdims=True) + RMS_EPS) * g).astype(x.dtype)


def rope(x, pos):
    half = x.shape[-1] // 2
    freqs = jnp.power(ROPE_THETA, -jnp.arange(half, dtype=F32) / half)
    ang = pos.astype(F32)[:, None] * freqs[None, :]
    cos, sin = jnp.cos(ang), jnp.sin(ang)
    x1 = x[..., :half].astype(F32)
    x2 = x[..., half:].astype(F32)
    return jnp.concatenate([x1 * cos - x2 * sin, x2 * cos + x1 * sin], axis=-1).astype(x.dtype)


def multiscale_pool(u, pool_w, pool_scale):
    b, s, _ = u.shape
    ng = len(POOL_WINDOWS)
    ug = u.reshape(b, s, ng, POOL_GROUP).astype(F32)
    cs = jnp.cumsum(ug, axis=1)
    pos = jnp.arange(s)
    means = []
    for g, w in enumerate(POOL_WINDOWS):
        c = cs[:, :, g]
        lagged = jnp.pad(c, ((0, 0), (w, 0), (0, 0)))[:, :s]
        count = jnp.minimum(pos + 1, w).astype(F32)[None, :, None]
        means.append((c - lagged) / count)
    diff = (jnp.stack(means, axis=2) - ug).astype(u.dtype)
    y = jnp.einsum('bsgc,gcd->bsgd', diff, pool_w).reshape(b, s, POOL_WIDTH)
    return y * pool_scale


def causal_dwconv(u, w, bias):
    c = u.shape[-1]
    out = lax.conv_general_dilated(
        u, w[:, None, :].astype(u.dtype), window_strides=(1,),
        padding=[(SSM_CONV - 1, 0)], dimension_numbers=('NWC', 'WIO', 'NWC'),
        feature_group_count=c)
    return out + bias


def mamba2_ssd(z, xbc, dt, conv_w, conv_b, dt_bias, a_log, d_skip, norm_w):
    b, s, _ = z.shape
    G, E, P, N, L = SSM_GROUPS, SSM_HEADS // SSM_GROUPS, SSM_HEAD_DIM, SSM_STATE, SSM_CHUNK
    nc = s // L
    xbc = jax.nn.silu(causal_dwconv(xbc, conv_w, conv_b))
    xs, bm, cm = jnp.split(xbc, [SSM_D_INNER, SSM_D_INNER + G * N], axis=-1)
    dt = jax.nn.softplus(dt.astype(F32) + dt_bias)
    a = -jnp.exp(a_log.astype(F32))
    xh = xs.reshape(b, nc, L, G, E, P).astype(F32)
    dtc = dt.reshape(b, nc, L, G, E)
    xdt = xh * dtc[..., None]
    da = dtc * a.reshape(G, E)
    bc = bm.reshape(b, nc, L, G, N).astype(F32)
    cc = cm.reshape(b, nc, L, G, N).astype(F32)
    acs = jnp.cumsum(da, axis=2).transpose(0, 1, 3, 4, 2)
    seg = acs[..., :, None] - acs[..., None, :]
    tri = jnp.tril(jnp.ones((L, L), dtype=bool))
    lmat = jnp.exp(jnp.where(tri, seg, -jnp.inf))
    cb = jnp.einsum('bclgn,bcsgn->bcgls', cc, bc)
    y_diag = jnp.einsum('bcgls,bcgels,bcsgep->bclgep', cb, lmat, xdt)
    decay_states = jnp.exp(acs[..., -1:] - acs)
    states = jnp.einsum('bclgn,bcgel,bclgep->bcgepn', bc, decay_states, xdt)
    chunk_decay = jnp.exp(acs[..., -1])

    def step(h, inp):
        st, dec = inp
        return h * dec[..., None, None] + st, h

    h0 = jnp.zeros((b, G, E, P, N), F32)
    _, prev = lax.scan(step, h0, (jnp.moveaxis(states, 1, 0), jnp.moveaxis(chunk_decay, 1, 0)))
    prev = jnp.moveaxis(prev, 0, 1)
    y_off = jnp.einsum('bclgn,bcgepn,bcgel->bclgep', cc, prev, jnp.exp(acs))
    y = y_diag + y_off + xh * d_skip.astype(F32).reshape(G, E)[:, :, None]
    y = y.reshape(b, s, SSM_D_INNER) * jax.nn.silu(z.astype(F32))
    return rms_norm(y, norm_w).astype(z.dtype)


def block_causal_attention(q, k, v, log_decay_cum):
    b, h, s, dk = q.shape
    nb = s // ATTN_BLOCK
    scale = dk ** -0.5
    qb = q.reshape(b, h, nb, ATTN_BLOCK, dk).transpose(2, 0, 1, 3, 4)
    fb = None if log_decay_cum is None else log_decay_cum.reshape(b, h, nb, ATTN_BLOCK).transpose(2, 0, 1, 3)
    kpos = jnp.arange(s)

    def one_block(args):
        qi, fi, i = args
        sc = jnp.einsum('bhqd,bhkd->bhqk', qi, k).astype(F32) * scale
        if fi is not None:
            sc = sc + fi[..., :, None] - log_decay_cum[:, :, None, :]
        qpos = i * ATTN_BLOCK + jnp.arange(ATTN_BLOCK)
        sc = jnp.where(kpos[None, :] <= qpos[:, None], sc, -jnp.inf)
        p = jax.nn.softmax(sc, axis=-1).astype(v.dtype)
        return jnp.einsum('bhqk,bhkd->bhqd', p, v)

    o = lax.map(one_block, (qb, fb, jnp.arange(nb)))
    return o.transpose(1, 0, 3, 2, 4).reshape(b, s, h * v.shape[-1])


def even_mixer(x, w_in, pool_w, pool_scale, conv_w, conv_b, dt_bias, a_log, d_skip, norm_w, w_out):
    proj = x @ w_in
    c1 = POOL_WIDTH
    c2 = c1 + SSM_D_INNER
    c3 = c2 + SSM_CONV_DIM
    u, z, xbc, dt = jnp.split(proj, [c1, c2, c3], axis=-1)
    y_pool = multiscale_pool(u, pool_w, pool_scale)
    y_ssm = mamba2_ssd(z, xbc, dt, conv_w, conv_b, dt_bias, a_log, d_skip, norm_w)
    return jnp.concatenate([y_pool, y_ssm], axis=-1) @ w_out


def odd_mixer(x, w_in, fgate_b, q_norm_w, w_uq, kv_norm_w, w_ukv, w_out):
    b, s, _ = x.shape
    proj = x @ w_in
    cuts = np.cumsum([FOX_WIDTH, FOX_WIDTH, FOX_WIDTH, FOX_HEADS, MLA_Q_RANK, MLA_KV_RANK]).tolist()
    qf, kf, vf, fl, cq, ckv, kr = jnp.split(proj, cuts, axis=-1)

    def heads(t, nh):
        return t.reshape(b, s, nh, -1).transpose(0, 2, 1, 3)

    log_f = jax.nn.log_sigmoid(fl.astype(F32) + fgate_b)
    fcum = jnp.cumsum(log_f, axis=1).transpose(0, 2, 1)
    o_fox = block_causal_attention(heads(qf, FOX_HEADS), heads(kf, FOX_HEADS), heads(vf, FOX_HEADS), fcum)

    pos = jnp.arange(s)
    q = heads(rms_norm(cq, q_norm_w) @ w_uq, MLA_HEADS)
    q = jnp.concatenate([q[..., :MLA_NOPE], rope(q[..., MLA_NOPE:], pos)], axis=-1)
    kv = heads(rms_norm(ckv, kv_norm_w) @ w_ukv, MLA_HEADS)
    k_rope = jnp.broadcast_to(rope(kr[:, None], pos), (b, MLA_HEADS, s, MLA_ROPE))
    k = jnp.concatenate([kv[..., :MLA_NOPE], k_rope], axis=-1)
    o_mla = block_causal_attention(q, k, kv[..., MLA_NOPE:], None)
    return jnp.concatenate([o_fox, o_mla], axis=-1) @ w_out


def swiglu(x, w_gate, w_up, w_down):
    return (jax.nn.silu(x @ w_gate) * (x @ w_up)) @ w_down


def setup_inputs(seed: int = 0) -> dict:
    key = jax.random.key(seed)
    ks = iter(jax.random.split(key, 40))

    def nrm(shape, std):
        return jax.random.normal(next(ks), shape, F32) * std

    def gain(shape):
        return 1.0 + 0.1 * jax.random.normal(next(ks), shape, F32)

    dt0 = jnp.exp(jax.random.uniform(next(ks), (N_EVEN, SSM_HEADS), F32, math.log(1e-3), math.log(1e-1)))
    return {
        "x": jax.random.normal(next(ks), (BATCH, SEQ, D_MODEL), F32),
        "even_w_in": nrm((N_EVEN, D_MODEL, EVEN_IN), D_MODEL ** -0.5),
        "pool_w": nrm((N_EVEN, len(POOL_WINDOWS), POOL_GROUP, POOL_GROUP), POOL_GROUP ** -0.5),
        "pool_scale": gain((N_EVEN, POOL_WIDTH)),
        "conv_w": nrm((N_EVEN, SSM_CONV, SSM_CONV_DIM), SSM_CONV ** -0.5),
        "conv_b": nrm((N_EVEN, SSM_CONV_DIM), 0.01),
        "dt_bias": dt0 + jnp.log(-jnp.expm1(-dt0)),
        "a_log": jnp.log(jax.random.uniform(next(ks), (N_EVEN, SSM_HEADS), F32, 1.0, 16.0)),
        "d_skip": gain((N_EVEN, SSM_HEADS)),
        "ssm_norm_w": gain((N_EVEN, SSM_D_INNER)),
        "even_w_out": nrm((N_EVEN, EVEN_MIX, D_MODEL), EVEN_MIX ** -0.5 * DEEPNORM_BETA),
        "odd_w_in": nrm((N_ODD, D_MODEL, ODD_IN), D_MODEL ** -0.5),
        "fgate_b": jax.random.uniform(next(ks), (N_ODD, FOX_HEADS), F32, 1.0, 5.0),
        "q_norm_w": gain((N_ODD, MLA_Q_RANK)),
        "w_uq": nrm((N_ODD, MLA_Q_RANK, MLA_HEADS * (MLA_NOPE + MLA_ROPE)), MLA_Q_RANK ** -0.5),
        "kv_norm_w": gain((N_ODD, MLA_KV_RANK)),
        "w_ukv": nrm((N_ODD, MLA_KV_RANK, MLA_HEADS * (MLA_NOPE + MLA_V)), MLA_KV_RANK ** -0.5),
        "odd_w_out": nrm((N_ODD, ODD_MIX, D_MODEL), ODD_MIX ** -0.5 * DEEPNORM_BETA),
        "ffn_w_gate": nrm((DEPTH, D_MODEL, D_FF), D_MODEL ** -0.5),
        "ffn_w_up": nrm((DEPTH, D_MODEL, D_FF), D_MODEL ** -0.5),
        "ffn_w_down": nrm((DEPTH, D_FF, D_MODEL), D_FF ** -0.5 * DEEPNORM_BETA),
        "ln_mix_g": gain((DEPTH, D_MODEL)),
        "ln_mix_b": nrm((DEPTH, D_MODEL), 0.02),
        "ln_ffn_g": gain((DEPTH, D_MODEL)),
        "ln_ffn_b": nrm((DEPTH, D_MODEL), 0.02),
    }


def reference(x, even_w_in, pool_w, pool_scale, conv_w, conv_b, dt_bias, a_log, d_skip, ssm_norm_w,
              even_w_out, odd_w_in, fgate_b, q_norm_w, w_uq, kv_norm_w, w_ukv, odd_w_out,
              ffn_w_gate, ffn_w_up, ffn_w_down, ln_mix_g, ln_mix_b, ln_ffn_g, ln_ffn_b):
    for l in range(DEPTH):
        i = l // 2
        if l % 2 == 0:
            h = even_mixer(x, even_w_in[i], pool_w[i], pool_scale[i], conv_w[i], conv_b[i], dt_bias[i],
                           a_log[i], d_skip[i], ssm_norm_w[i], even_w_out[i])
        else:
            h = odd_mixer(x, odd_w_in[i], fgate_b[i], q_norm_w[i], w_uq[i], kv_norm_w[i], w_ukv[i], odd_w_out[i])
        x = layer_norm(DEEPNORM_ALPHA * x + h, ln_mix_g[l], ln_mix_b[l])
        x = layer_norm(DEEPNORM_ALPHA * x + swiglu(x, ffn_w_gate[l], ffn_w_up[l], ffn_w_down[l]),
                       ln_ffn_g[l], ln_ffn_b[l])
    return x
```

```cpp
#include <hip/hip_runtime.h>
#include <hip/hip_cooperative_groups.h>
#include <cstdio>
#include <cstdint>
#include <type_traits>
namespace cg = cooperative_groups;

#define DI __device__ __forceinline__
typedef unsigned short bf16_t;
typedef short bf16x8 __attribute__((ext_vector_type(8)));
typedef short s16x4 __attribute__((ext_vector_type(4)));
typedef float f32x16 __attribute__((ext_vector_type(16)));
typedef float f32x4 __attribute__((ext_vector_type(4)));
typedef float f32x2 __attribute__((ext_vector_type(2)));
typedef __bf16 bf16x2v __attribute__((ext_vector_type(2)));
typedef unsigned u32x4 __attribute__((ext_vector_type(4)));
typedef unsigned u32x2 __attribute__((ext_vector_type(2)));

#ifndef PROBE_DUP
#define PROBE_DUP 0
#endif
#ifndef N_LAUNCH_MODE
#define N_LAUNCH_MODE 1
#endif

constexpr int T_ = 16384, S_ = 8192;
constexpr float ALPHA = 1.681792830507429f;
constexpr float LOG2E = 1.4426950408889634f;
constexpr float QS_FOX = 0.18033688011112042f;
constexpr float QS_MLA = 0.14724444602590306f;
constexpr size_t MB = 1u << 20;

constexpr size_t OFF_XB = 0;
constexpr size_t OFF_WM = 32 * MB;
constexpr size_t OFF_WF = 42 * MB;
constexpr size_t OFF_MISC = 60 * MB;
constexpr size_t OFF_R = 64 * MB;
constexpr size_t OFF_XS = 236 * MB;
constexpr size_t WS_NEED = 240 * MB;
constexpr size_t MISC_ROPE = 0;
constexpr size_t MISC_SSQ = 1 * MB;
constexpr size_t MISC_CNT = 1 * MB + 512 * 1024;
constexpr size_t MISC_NRM = 1 * MB + 768 * 1024;
constexpr size_t RE_U = 0, RE_Z = 16 * MB, RE_XBC = 48 * MB  , RE_DT = 96 * MB, RE_DTV = 97 * MB, RE_ACS = 98 * MB,
                 RE_BN = 99 * MB, RE_CN = 107 * MB, RE_BT = 115 * MB, RE_XST = 123 * MB, RE_DIFF = 155 * MB;
constexpr size_t RO_QF = 0, RO_KF = 16 * MB, RO_VF = 32 * MB, RO_CQ = 48 * MB, RO_CKV = 64 * MB, RO_KR = 72 * MB, RO_FL = 73 * MB,
                 RO_QM = 74 * MB, RO_KN = 98 * MB, RO_VM = 114 * MB, RO_FC = 130 * MB, RO_OCAT = 131 * MB;
constexpr size_t WE_IN = 0, WE_POOL = 3200 * 1024, WE_OUT = WE_POOL + 4 * 128 * 128;
constexpr size_t WO_IN = 0, WO_UQ = 2432 * 1024, WO_UKV = WO_UQ + 768 * 512, WO_OUT = WO_UKV + 1024 * 256;
constexpr size_t WF_GU = 0, WF_DN = 5632 * 1024;

constexpr int SMEM_BYTES = 73728 + 64;

struct P {
    const float *x, *even_w_in, *pool_w, *pool_scale, *conv_w, *conv_b, *dt_bias, *a_log, *d_skip, *ssm_norm_w, *even_w_out,
        *odd_w_in, *fgate_b, *q_norm_w, *w_uq, *kv_norm_w, *w_ukv, *odd_w_out, *ffn_w_gate, *ffn_w_up, *ffn_w_down,
        *ln_mix_g, *ln_mix_b, *ln_ffn_g, *ln_ffn_b;
    float* out;
    unsigned char* ws;
    long long ph_lo, ph_hi;
};

struct Ctx { int tid, bid, nb; };

__constant__ double ROPE_FREQ[16] = {1.0, 0.5623413251903491, 0.31622776601683794, 0.1778279410038923, 0.1, 0.05623413251903491,
    0.03162277660168379, 0.01778279410038923, 0.01, 0.005623413251903491, 0.0031622776601683794, 0.0017782794100389228, 0.001,
    0.0005623413251903491, 0.00031622776601683794, 0.00017782794100389227};

DI unsigned pk2(float a, float b) { f32x2 v = {a, b}; bf16x2v r = __builtin_convertvector(v, bf16x2v); return __builtin_bit_cast(unsigned, r); }
DI bf16_t f2bf(float a) { return (bf16_t)(pk2(a, 0.f) & 0xffffu); }
DI float bf2f(bf16_t v) { return __uint_as_float((unsigned)v << 16); }
DI float bflo(unsigned u) { return __uint_as_float(u << 16); }
DI float bfhi(unsigned u) { return __uint_as_float(u & 0xffff0000u); }
DI int crow(int i, int h) { return (i & 3) + 8 * (i >> 2) + 4 * h; }
DI f32x16 mfma32(bf16x8 a, bf16x8 b, f32x16 c) { return __builtin_amdgcn_mfma_f32_32x32x16_bf16(a, b, c, 0, 0, 0); }
DI f32x16 zero16() { f32x16 z; for (int i = 0; i < 16; ++i) z[i] = 0.f; return z; }
template <int s> DI bf16x8 pack8(const f32x16& x) {
    u32x4 p;
    p.x = pk2(x[8 * s + 0], x[8 * s + 1]); p.y = pk2(x[8 * s + 2], x[8 * s + 3]);
    p.z = pk2(x[8 * s + 4], x[8 * s + 5]); p.w = pk2(x[8 * s + 6], x[8 * s + 7]);
    return __builtin_bit_cast(bf16x8, p);
}
DI float silu_f(float v) { return v * __builtin_amdgcn_rcpf(1.f + __expf(-v)); }

template <int NT, bool HOOK, bool PIPE = true, class Epi, class Hook>
DI void gemm_tile(const Ctx& cx, unsigned char* smem, const bf16_t* __restrict__ A, int lda, const bf16_t* __restrict__ Bt, int ldb, int K, int m0, int n0,
                  const Epi& epi, const Hook& hook, int hook_kt) {
    constexpr int BN = 64 * NT, NB = BN / 32;
    constexpr bool DBUF = (NT == 2);
    const int tid = cx.tid, lane = tid & 63, w = __builtin_amdgcn_readfirstlane(tid >> 6), wm = w >> 1, wn = w & 1, r = lane & 31, h = lane >> 5;
    bf16_t* As = (bf16_t*)smem;
    bf16_t* Bs = As + (DBUF ? 2 : 1) * 128 * 72;
    f32x16 acc[2][NT];
#pragma unroll
    for (int a = 0; a < 2; ++a)
#pragma unroll
        for (int b = 0; b < NT; ++b) acc[a][b] = zero16();
    const int nk = K >> 6;
    const int prow = tid >> 3, pch = tid & 7;
    const bf16_t* ga = A + (size_t)(m0 + prow) * lda + pch * 8;
    const bf16_t* gb = Bt + (size_t)(n0 + prow) * ldb + pch * 8;
    u32x4 ra[4], rb[NB];
#pragma unroll
    for (int i = 0; i < 4; ++i) ra[i] = *(const u32x4*)(ga + (size_t)(32 * i) * lda);
#pragma unroll
    for (int i = 0; i < NB; ++i) rb[i] = *(const u32x4*)(gb + (size_t)(32 * i) * ldb);
#pragma unroll
    for (int i = 0; i < 4; ++i) *(u32x4*)(As + (prow + 32 * i) * 72 + pch * 8) = ra[i];
#pragma unroll
    for (int i = 0; i < NB; ++i) *(u32x4*)(Bs + (prow + 32 * i) * 72 + pch * 8) = rb[i];
    __syncthreads();
    for (int kt = 0; kt < nk; ++kt) {
        const int cur = DBUF ? (kt & 1) : 0;
        if (HOOK) { if (kt == hook_kt + 1) hook(acc, m0 + 64 * wm, lane); }
        if (kt + 1 < nk) {
#pragma unroll
            for (int i = 0; i < 4; ++i) ra[i] = *(const u32x4*)(ga + (size_t)(32 * i) * lda + (kt + 1) * 64);
#pragma unroll
            for (int i = 0; i < NB; ++i) rb[i] = *(const u32x4*)(gb + (size_t)(32 * i) * ldb + (kt + 1) * 64);
        }
        const bf16_t* as = As + cur * 128 * 72 + (64 * wm + r) * 72 + 8 * h;
        const bf16_t* bs = Bs + cur * BN * 72 + (32 * NT * wn + r) * 72 + 8 * h;
        __builtin_amdgcn_s_setprio(1);
        {
            bf16x8 a0 = *(const bf16x8*)(as), a1 = *(const bf16x8*)(as + 32 * 72), bc = *(const bf16x8*)(bs);
            bf16x8 a0n = a0, a1n = a1;
#pragma unroll
            for (int step = 0; step < 4 * NT; ++step) {
                const int ks = step / NT, nt = step % NT;
                bf16x8 bn = bc;
                if (step + 1 < 4 * NT) bn = *(const bf16x8*)(bs + ((step + 1) % NT) * 32 * 72 + ((step + 1) / NT) * 16);
                if (nt == NT - 2 && ks < 3) { a0n = *(const bf16x8*)(as + (ks + 1) * 16); a1n = *(const bf16x8*)(as + 32 * 72 + (ks + 1) * 16); }
                if (PIPE) __builtin_amdgcn_sched_barrier(0);
                acc[0][nt] = mfma32(a0, bc, acc[0][nt]); acc[1][nt] = mfma32(a1, bc, acc[1][nt]);
                bc = bn;
                if (nt == NT - 1) { a0 = a0n; a1 = a1n; }
            }
        }
        __builtin_amdgcn_s_setprio(0);
        if (!DBUF) __syncthreads();
        if (kt + 1 < nk) {
            const int nx = DBUF ? (cur ^ 1) : 0;
#pragma unroll
            for (int i = 0; i < 4; ++i) *(u32x4*)(As + nx * 128 * 72 + (prow + 32 * i) * 72 + pch * 8) = ra[i];
#pragma unroll
            for (int i = 0; i < NB; ++i) *(u32x4*)(Bs + nx * BN * 72 + (prow + 32 * i) * 72 + pch * 8) = rb[i];
        }
        __syncthreads();
    }
    epi(acc, m0 + 64 * wm, n0 + 32 * NT * wn, lane);
}
struct NoHook { template <class ACC> DI void operator()(ACC&, int, int) const {} };

template <bool HOOK, bool REM = true, bool PIPE = true, bool HALF = false, class Epi, class Hook>
DI void gemm_phase(const Ctx& cx, unsigned char* smem, const bf16_t* A, int lda, const bf16_t* Bt, int ldb, int K, int M, int N, const Epi& epi, const Hook& hook, int hook_kt) {
    const int tn = N >> 8, tm = M >> 7;
    const int x = cx.bid & 7, l = cx.bid >> 3, c = cx.nb >> 3, pr = tm >> 3, len = pr * tn;
    const int rounds = len / c, rem = len - rounds * c, nh = (HALF && rem > 0 && 2 * rem <= c) ? 2 * rem : 0, lenfull = nh ? rounds * c : len;
    for (int sidx = l; sidx < lenfull; sidx += c) gemm_tile<4, HOOK, PIPE>(cx, smem, A, lda, Bt, ldb, K, (x * pr + sidx / tn) * 128, (sidx % tn) * 256, epi, hook, hook_kt);
    if (REM || HALF) {
        const int nrem = (REM && (N & 128)) ? pr : 0;
        for (int u = c - 1 - l; u < nh + nrem; u += c) {
            int m0, n0;
            if (u < nh) { const int sidx = lenfull + (u >> 1); m0 = (x * pr + sidx / tn) * 128; n0 = (sidx % tn) * 256 + (u & 1) * 128; }
            else { m0 = (x * pr + (u - nh)) * 128; n0 = tn * 256; }
            gemm_tile<2, HOOK>(cx, smem, A, lda, Bt, ldb, K, m0, n0, epi, hook, hook_kt);
        }
    }
}
template <int NT, class F> DI void epi_each(f32x16 (&acc)[2][NT], int mb, int nb, int lane, const F& f) {
    const int h = lane >> 5, c = lane & 31;
#pragma unroll
    for (int mt = 0; mt < 2; ++mt)
#pragma unroll
        for (int i4 = 0; i4 < 4; ++i4) {
            int rb = mb + 32 * mt + 8 * i4 + 4 * h;
            asm volatile("" : "+v"(rb));
#pragma unroll
            for (int nt = 0; nt < NT; ++nt)
#pragma unroll
                for (int j = 0; j < 4; ++j) f(rb + j, nb + 32 * nt + c, acc[mt][nt][4 * i4 + j]);
        }
}

template <class F> DI void conv_task(const Ctx& cx, unsigned char* smem, bf16_t* dst, int N, int K, const F& f) {
    float* tile = (float*)smem;
    const int tid = cx.tid, tx = tid & 63, ty = tid >> 6;
    const int tk = K >> 6, nt = (N >> 6) * tk;
    float v[16];
    int t = cx.bid;
    if (t < nt) {
        const int n0 = (t / tk) * 64, k0 = (t % tk) * 64;
#pragma unroll
        for (int i = 0; i < 16; ++i) v[i] = f(k0 + ty + 4 * i, n0 + tx);
    }
    while (t < nt) {
        const int n0 = (t / tk) * 64, k0 = (t % tk) * 64;
#pragma unroll
        for (int i = 0; i < 16; ++i) tile[(ty + 4 * i) * 65 + tx] = v[i];
        __syncthreads();
        const int tnx = t + cx.nb;
        if (tnx < nt) {
            const int n1 = (tnx / tk) * 64, k1 = (tnx % tk) * 64;
#pragma unroll
            for (int i = 0; i < 16; ++i) v[i] = f(k1 + ty + 4 * i, n1 + tx);
        }
        const int nl = tid >> 2, ks = (tid & 3) * 16;
        u32x4 o0, o1;
        o0.x = pk2(tile[(ks + 0) * 65 + nl], tile[(ks + 1) * 65 + nl]); o0.y = pk2(tile[(ks + 2) * 65 + nl], tile[(ks + 3) * 65 + nl]);
        o0.z = pk2(tile[(ks + 4) * 65 + nl], tile[(ks + 5) * 65 + nl]); o0.w = pk2(tile[(ks + 6) * 65 + nl], tile[(ks + 7) * 65 + nl]);
        o1.x = pk2(tile[(ks + 8) * 65 + nl], tile[(ks + 9) * 65 + nl]); o1.y = pk2(tile[(ks + 10) * 65 + nl], tile[(ks + 11) * 65 + nl]);
        o1.z = pk2(tile[(ks + 12) * 65 + nl], tile[(ks + 13) * 65 + nl]); o1.w = pk2(tile[(ks + 14) * 65 + nl], tile[(ks + 15) * 65 + nl]);
        bf16_t* d = dst + (size_t)(n0 + nl) * K + k0 + ks;
        *(u32x4*)d = o0; *(u32x4*)(d + 8) = o1;
        __syncthreads();
        t = tnx;
    }
}
DI void convert_mixer_weights(const Ctx& cx, const P& p, unsigned char* smem, int layer) {
    bf16_t* wm = (bf16_t*)(p.ws + OFF_WM);
    const int li = layer >> 1;
    if ((layer & 1) == 0) {
        const float* win = p.even_w_in + (size_t)li * 1024 * 3088;
        conv_task(cx, smem, wm + WE_IN, 3200, 1024, [=](int k, int n) { return n < 3088 ? win[(size_t)k * 3088 + n] : 0.f; });
        const float* pw = p.pool_w + (size_t)li * 4 * 128 * 128;
        conv_task(cx, smem, wm + WE_POOL, 512, 128, [=](int k, int n) { return pw[(size_t)(n >> 7) * 16384 + k * 128 + (n & 127)]; });
        const float* wo = p.even_w_out + (size_t)li * 1536 * 1024;
        conv_task(cx, smem, wm + WE_OUT, 1024, 1536, [=](int k, int n) { const int kr = k < 1024 ? k + 512 : k - 1024; return wo[(size_t)kr * 1024 + n]; });
    } else {
        const float* win = p.odd_w_in + (size_t)li * 1024 * 2344;
        conv_task(cx, smem, wm + WO_IN, 2432, 1024, [=](int k, int n) {
            int c;
            if (n < 1536) c = n; else if (n < 2048) c = 1544 + (n - 1536); else if (n < 2304) c = 2056 + (n - 2048);
            else if (n < 2336) c = 2312 + (n - 2304); else if (n < 2344) c = 1536 + (n - 2336); else c = -1;
            return c >= 0 ? win[(size_t)k * 2344 + c] : 0.f; });
        const float* uq = p.w_uq + (size_t)li * 512 * 768; const float* qn = p.q_norm_w + li * 512;
        conv_task(cx, smem, wm + WO_UQ, 768, 512, [=](int k, int n) { return uq[(size_t)k * 768 + n] * qn[k]; });
        const float* ukv = p.w_ukv + (size_t)li * 256 * 1024; const float* kn = p.kv_norm_w + li * 256;
        conv_task(cx, smem, wm + WO_UKV, 1024, 256, [=](int k, int n) { return ukv[(size_t)k * 1024 + n] * kn[k]; });
        const float* wo = p.odd_w_out + (size_t)li * 1024 * 1024;
        conv_task(cx, smem, wm + WO_OUT, 1024, 1024, [=](int k, int n) { return wo[(size_t)k * 1024 + n]; });
    }
}
DI void convert_ffn_weights(const Ctx& cx, const P& p, unsigned char* smem, int layer) {
    bf16_t* wf = (bf16_t*)(p.ws + OFF_WF);
    const float* g = p.ffn_w_gate + (size_t)layer * 1024 * 2816; const float* u = p.ffn_w_up + (size_t)layer * 1024 * 2816;
    conv_task(cx, smem, wf + WF_GU, 5632, 1024, [=](int k, int n) { const int q = n >> 6, r = n & 63; return r < 32 ? g[(size_t)k * 2816 + 32 * q + r] : u[(size_t)k * 2816 + 32 * q + r - 32]; });
    const float* d = p.ffn_w_down + (size_t)layer * 2816 * 1024;
    conv_task(cx, smem, wf + WF_DN, 1024, 2816, [=](int k, int n) { return d[(size_t)k * 1024 + n]; });
}

DI void phase_prep(const Ctx& cx, const P& p, unsigned char* smem) {
    const size_t gt = (size_t)cx.bid * 256 + cx.tid, gs = (size_t)cx.nb * 256;
    bf16_t* xb = (bf16_t*)(p.ws + OFF_XB);
    for (size_t i = gt; i < (size_t)T_ * 1024 / 4; i += gs) {
        const f32x4 v = *(const f32x4*)(p.x + i * 4);
        u32x2 o; o.x = pk2(v[0], v[1]); o.y = pk2(v[2], v[3]);
        *(u32x2*)(xb + i * 4) = o;
    }
    f32x2* rope = (f32x2*)(p.ws + OFF_MISC + MISC_ROPE);
    for (size_t i = gt; i < (size_t)S_ * 16; i += gs) {
        const int pos = (int)(i >> 4), fi = (int)(i & 15);
        const double ang = (double)pos * ROPE_FREQ[fi];
        const double k = __builtin_rint(ang * 0.15915494309189535);
        const float rr = (float)(ang - k * 6.283185307179586);
        rope[i] = (f32x2){cosf(rr), sinf(rr)};
    }
    float* ssq = (float*)(p.ws + OFF_MISC + MISC_SSQ);
    for (size_t i = gt; i < (size_t)4 * 2 * T_; i += gs) ssq[i] = 0.f;
    int* cnt = (int*)(p.ws + OFF_MISC + MISC_CNT);
    if (gt < 16) cnt[gt] = 0;
    if (gt < 128) ((unsigned*)(p.ws + OFF_MISC + MISC_NRM))[gt] = 0u;
    convert_mixer_weights(cx, p, smem, 0);
}

DI void phase_ln(const Ctx& cx, const P& p, const float* g, const float* b, bool write_xb) {
    const int lane = cx.tid & 63, wv = __builtin_amdgcn_readfirstlane(cx.tid >> 6);
    bf16_t* xb = (bf16_t*)(p.ws + OFF_XB);
    for (int row = cx.bid * 4 + wv; row < T_; row += cx.nb * 4) {
        float* xr = p.out + (size_t)row * 1024;
        f32x4 v[4]; float s = 0.f;
#pragma unroll
        for (int i = 0; i < 4; ++i) { v[i] = *(const f32x4*)(xr + i * 256 + lane * 4); s += (v[i][0] + v[i][1]) + (v[i][2] + v[i][3]); }
#pragma unroll
        for (int o = 32; o >= 1; o >>= 1) s += __shfl_xor(s, o);
        const float mu = s * (1.f / 1024.f); float q = 0.f;
#pragma unroll
        for (int i = 0; i < 4; ++i) { const f32x4 d = v[i] - mu; q += (d[0] * d[0] + d[1] * d[1]) + (d[2] * d[2] + d[3] * d[3]); }
#pragma unroll
        for (int o = 32; o >= 1; o >>= 1) q += __shfl_xor(q, o);
        const float rstd = 1.0f / sqrtf(q * (1.f / 1024.f) + 1e-5f);
#pragma unroll
        for (int i = 0; i < 4; ++i) {
            const int c = i * 256 + lane * 4;
            const f32x4 gg = *(const f32x4*)(g + c), bb = *(const f32x4*)(b + c);
            const f32x4 o = (v[i] - mu) * rstd * gg + bb;
            *(f32x4*)(xr + c) = o;
            if (write_xb) { u32x2 w; w.x = pk2(o[0], o[1]); w.y = pk2(o[2], o[3]); *(u32x2*)(xb + (size_t)row * 1024 + c) = w; }
        }
    }
}

constexpr size_t MISC_LNCNT = 2 * MB + 16384;
struct EpiResidLN {
    float* X; const float* Xin; bf16_t* Xb; const float* g; const float* b; unsigned long long* xs; unsigned* cnt; unsigned inst; unsigned char* smem; int tid;
    template <int NT> DI void operator()(f32x16 (&acc)[2][NT], int mb, int nb, int lane) const {
        const int h = lane >> 5, c = lane & 31, wn = __builtin_amdgcn_readfirstlane((tid >> 6) & 1);
        const int panel = mb >> 7, ct = nb / (64 * NT), ntn = 1024 / (64 * NT);
        f32x2* Pl = (f32x2*)smem;
        f32x2* Sl = Pl + 256;
#pragma unroll
        for (int mt = 0; mt < 2; ++mt)
#pragma unroll
            for (int i4 = 0; i4 < 4; ++i4) {
                int rb = mb + 32 * mt + 8 * i4 + 4 * h;
                asm volatile("" : "+v"(rb));
#pragma unroll
                for (int j = 0; j < 4; ++j) {
                    unsigned xo = (unsigned)((rb + j) * 1024 + nb + c);
                    asm volatile("" : "+v"(xo));
                    float sm = 0.f, sq = 0.f;
#pragma unroll
                    for (int nt = 0; nt < NT; ++nt) { const float v = ALPHA * Xin[xo + 32 * nt] + acc[mt][nt][4 * i4 + j]; acc[mt][nt][4 * i4 + j] = v; sm += v; sq += v * v; }
                    sm += __shfl_xor(sm, 1); sq += __shfl_xor(sq, 1); sm += __shfl_xor(sm, 2); sq += __shfl_xor(sq, 2); sm += __shfl_xor(sm, 4); sq += __shfl_xor(sq, 4);
                    sm += __shfl_xor(sm, 8); sq += __shfl_xor(sq, 8); sm += __shfl_xor(sm, 16); sq += __shfl_xor(sq, 16);
                    if (c == 0) Pl[((rb + j) & 127) * 2 + wn] = (f32x2){sm, sq};
                }
            }
        __syncthreads();
        if (tid < 128) {
            const f32x2 p0 = Pl[tid * 2], p1 = Pl[tid * 2 + 1];
            const unsigned long long val = ((unsigned long long)__float_as_uint(p0.y + p1.y) << 32) | __float_as_uint(p0.x + p1.x);
            __hip_atomic_store(xs + (((size_t)inst * T_ + panel * 128 + tid) * 4 + ct), val, __ATOMIC_RELAXED, __HIP_MEMORY_SCOPE_AGENT);
        }
        asm volatile("s_waitcnt vmcnt(0)" ::: "memory");
        __syncthreads();
        if (tid == 0) {
            __hip_atomic_fetch_add(cnt + panel, 1u, __ATOMIC_RELAXED, __HIP_MEMORY_SCOPE_AGENT);
            const unsigned want = (unsigned)ntn * (inst + 1u);
            unsigned sp = 0;
            while (__hip_atomic_load(cnt + panel, __ATOMIC_RELAXED, __HIP_MEMORY_SCOPE_AGENT) < want) { __builtin_amdgcn_s_sleep(1); if (++sp > (1u << 22)) break; }
            __builtin_amdgcn_fence(__ATOMIC_ACQUIRE, "agent");
        }
        __syncthreads();
        if (tid < 128) {
            const unsigned long long* sl = xs + ((size_t)inst * T_ + panel * 128 + tid) * 4;
            float sm = 0.f, sq = 0.f;
#pragma unroll
            for (int t = 0; t < 4; ++t) if (t < ntn) { const unsigned long long wv = __hip_atomic_load(sl + t, __ATOMIC_RELAXED, __HIP_MEMORY_SCOPE_AGENT); sm += __uint_as_float((unsigned)wv); sq += __uint_as_float((unsigned)(wv >> 32)); }
            const float mu = sm * (1.f / 1024.f), var = fmaxf(sq * (1.f / 1024.f) - mu * mu, 0.f);
            Sl[tid] = (f32x2){mu, 1.0f / sqrtf(var + 1e-5f)};
        }
        __syncthreads();
        float gg[NT], bb[NT];
#pragma unroll
        for (int nt = 0; nt < NT; ++nt) { gg[nt] = g[nb + 32 * nt + c]; bb[nt] = b[nb + 32 * nt + c]; }
#pragma unroll
        for (int mt = 0; mt < 2; ++mt)
#pragma unroll
            for (int i4 = 0; i4 < 4; ++i4) {
                int rb = mb + 32 * mt + 8 * i4 + 4 * h;
                asm volatile("" : "+v"(rb));
#pragma unroll
                for (int j = 0; j < 4; ++j) {
                    const f32x2 ms = Sl[(rb + j) & 127];
                    unsigned off = (unsigned)((rb + j) * 1024 + nb + c);
                    asm volatile("" : "+v"(off));
#pragma unroll
                    for (int nt = 0; nt < NT; ++nt) {
                        const float o = (acc[mt][nt][4 * i4 + j] - ms.x) * ms.y * gg[nt] + bb[nt];
                        X[off + 32 * nt] = o;
                        if (Xb) Xb[off + 32 * nt] = f2bf(o);
                    }
                }
            }
        __syncthreads();
    }
};
DI EpiResidLN make_ln_epi(const Ctx& cx, const P& p, unsigned char* smem, int layer, int which  ) {
    EpiResidLN e;
    e.X = p.out; e.Xin = (layer == 0 && which == 0) ? p.x : p.out; e.Xb = (layer == 3 && which == 1) ? (bf16_t*)nullptr : (bf16_t*)(p.ws + OFF_XB);
    e.g = (which ? p.ln_ffn_g : p.ln_mix_g) + layer * 1024; e.b = (which ? p.ln_ffn_b : p.ln_mix_b) + layer * 1024;
    e.xs = (unsigned long long*)(p.ws + OFF_XS); e.cnt = (unsigned*)(p.ws + OFF_MISC + MISC_LNCNT); e.inst = (unsigned)(layer * 2 + which);
    e.smem = smem; e.tid = cx.tid;
    return e;
}

DI void phase_ffn1(const Ctx& cx, const P& p, unsigned char* smem) {
    bf16_t* H = (bf16_t*)(p.ws + OFF_R);
    const int wv = __builtin_amdgcn_readfirstlane(cx.tid >> 6);
    auto epi = [=](auto& acc, int mb, int nb, int lane) {
        constexpr int NT = sizeof(acc[0]) / sizeof(f32x16), OC = 16 * NT, RS = OC + 8, CPR = OC / 8;
        asm volatile("" : "+v"(lane));
        const int h = lane >> 5, c = lane & 31;
        bf16_t* stg = (bf16_t*)smem + wv * (64 * RS);
#pragma unroll
        for (int np = 0; np < NT / 2; ++np)
#pragma unroll
            for (int mt = 0; mt < 2; ++mt)
#pragma unroll
                for (int i = 0; i < 16; ++i) {
                    const float gv = acc[mt][2 * np][i], uv = acc[mt][2 * np + 1][i];
                    stg[(32 * mt + crow(i, h)) * RS + 32 * np + c] = f2bf(silu_f(gv) * uv);
                    if ((i & 3) == 3) __builtin_amdgcn_sched_barrier(0);
                }
        bf16_t* hb = H + (size_t)mb * 2816 + (nb >> 6) * 32;
#pragma unroll
        for (int q = 0; q < CPR; ++q) {
            const int idx = q * 64 + lane, rl = idx / CPR, ch = idx % CPR;
            const u32x4 v = *(const u32x4*)(stg + rl * RS + ch * 8);
            *(u32x4*)(hb + (size_t)rl * 2816 + ch * 8) = v;
        }
        __syncthreads();
    };
    gemm_phase<false, false, true, true>(cx, smem, (const bf16_t*)(p.ws + OFF_XB), 1024, (const bf16_t*)(p.ws + OFF_WF) + WF_GU, 1024, 1024, T_, 5632, epi, NoHook(), -1);
}
DI void phase_ffn2(const Ctx& cx, const P& p, unsigned char* smem, int layer) {
    const EpiResidLN epi = make_ln_epi(cx, p, smem, layer, 1);
    gemm_phase<false, false>(cx, smem, (const bf16_t*)(p.ws + OFF_R), 2816, (const bf16_t*)(p.ws + OFF_WF) + WF_DN, 2816, 2816, T_, 1024, epi, NoHook(), -1);
}

DI void phase_even_in(const Ctx& cx, const P& p, unsigned char* smem) {
    unsigned char* R = p.ws + OFF_R;
    bf16_t* U = (bf16_t*)(R + RE_U); bf16_t* Z = (bf16_t*)(R + RE_Z); bf16_t* XBC = (bf16_t*)(R + RE_XBC); float* DT = (float*)(R + RE_DT);
    const int wv = __builtin_amdgcn_readfirstlane(cx.tid >> 6);
    auto epi = [=](auto& acc, int mb, int nb, int lane) {
        constexpr int NT = sizeof(acc[0]) / sizeof(f32x16);
        if constexpr (NT == 4) {
            constexpr int RS = 136;
            asm volatile("" : "+v"(lane));
            const int h = lane >> 5, c = lane & 31;
            bf16_t* stg = (bf16_t*)smem + wv * (64 * RS);
#pragma unroll
            for (int mt = 0; mt < 2; ++mt)
#pragma unroll
                for (int nt = 0; nt < 4; ++nt)
#pragma unroll
                    for (int i = 0; i < 16; ++i) stg[(32 * mt + crow(i, h)) * RS + 32 * nt + c] = f2bf(acc[mt][nt][i]);
            bf16_t* db; int ld;
            if (nb < 512) { db = U + nb; ld = 512; } else if (nb < 1536) { db = Z + (nb - 512); ld = 1024; } else { db = XBC + (nb - 1536); ld = 1536; }
            db += (size_t)mb * ld;
#pragma unroll
            for (int q = 0; q < 16; ++q) {
                const int idx = q * 64 + lane, rl = idx >> 4, ch = idx & 15;
                const u32x4 v = *(const u32x4*)(stg + rl * RS + ch * 8);
                *(u32x4*)(db + (size_t)rl * ld + ch * 8) = v;
            }
            __syncthreads();
        } else {
            epi_each(acc, mb, nb, lane, [=](int row, int col, float v) {
                if (col < 512) U[(size_t)row * 512 + col] = f2bf(v);
                else if (col < 1536) Z[(size_t)row * 1024 + col - 512] = f2bf(v);
                else if (col < 3072) XBC[(size_t)row * 1536 + col - 1536] = f2bf(v);
                else if (col < 3088) DT[(size_t)row * 16 + col - 3072] = v;
            });
        }
    };
    gemm_phase<false>(cx, smem, (const bf16_t*)(p.ws + OFF_XB), 1024, (const bf16_t*)(p.ws + OFF_WM) + WE_IN, 1024, 1024, T_, 3200, epi, NoHook(), -1);
}

DI void phase_even_conv(const Ctx& cx, const P& p, unsigned char* smem, int li) {
    unsigned char* R = p.ws + OFF_R;
    const bf16_t* U = (const bf16_t*)(R + RE_U); const bf16_t* XBC = (const bf16_t*)(R + RE_XBC); const float* DT = (const float*)(R + RE_DT);
    float* DTV = (float*)(R + RE_DTV); float* ACS = (float*)(R + RE_ACS);
    bf16_t* BN = (bf16_t*)(R + RE_BN); bf16_t* CN = (bf16_t*)(R + RE_CN); bf16_t* BT = (bf16_t*)(R + RE_BT); bf16_t* XST = (bf16_t*)(R + RE_XST);
    bf16_t* DIFF = (bf16_t*)(R + RE_DIFF);
    const float* cw = p.conv_w + (size_t)li * 4 * 1536; const float* cb = p.conv_b + (size_t)li * 1536;
    const float* dtb = p.dt_bias + li * 16; const float* alog = p.a_log + li * 16;
    const int tid = cx.tid;
    float* sseg = (float*)smem;
    for (int u = cx.bid; u < 128 * 9; u += cx.nb) {
        const int bc = u / 9, sub = u % 9, b = bc >> 6, c = bc & 63, t0 = b * S_ + c * 128, pos0 = c * 128;
        if (sub < 6) {
            const int ch = sub * 256 + tid;
            const float w0 = cw[ch], w1 = cw[1536 + ch], w2 = cw[2 * 1536 + ch], w3 = cw[3 * 1536 + ch], bias = cb[ch];
            float x0 = pos0 >= 3 ? bf2f(XBC[(size_t)(t0 - 3) * 1536 + ch]) : 0.f;
            float x1 = pos0 >= 2 ? bf2f(XBC[(size_t)(t0 - 2) * 1536 + ch]) : 0.f;
            float x2 = pos0 >= 1 ? bf2f(XBC[(size_t)(t0 - 1) * 1536 + ch]) : 0.f;
            for (int l = 0; l < 128; l += 32) {
                float xin[32];
#pragma unroll
                for (int j = 0; j < 32; ++j) xin[j] = bf2f(XBC[(size_t)(t0 + l + j) * 1536 + ch]);
#pragma unroll
                for (int q8 = 0; q8 < 4; ++q8) {
                    float o[8];
#pragma unroll
                    for (int j = 0; j < 8; ++j) {
                        const float x3 = xin[8 * q8 + j];
                        const float y = w0 * x0 + w1 * x1 + w2 * x2 + w3 * x3 + bias;
                        o[j] = silu_f(y); x0 = x1; x1 = x2; x2 = x3;
                    }
                    const int lq = l + 8 * q8;
                    u32x4 pk; pk.x = pk2(o[0], o[1]); pk.y = pk2(o[2], o[3]); pk.z = pk2(o[4], o[5]); pk.w = pk2(o[6], o[7]);
                    if (sub < 4) { *(u32x4*)(XST + ((size_t)b * 1024 + ch) * S_ + pos0 + lq) = pk; }
                    else if (sub == 4) {
                        const int cc = ch - 1024;
                        *(u32x4*)(BT + ((size_t)b * 256 + cc) * S_ + pos0 + lq) = pk;
#pragma unroll
                        for (int j = 0; j < 8; ++j) BN[(size_t)(t0 + lq + j) * 256 + cc] = f2bf(o[j]);
                    } else {
                        const int cc = ch - 1280;
#pragma unroll
                        for (int j = 0; j < 8; ++j) CN[(size_t)(t0 + lq + j) * 256 + cc] = f2bf(o[j]);
                    }
                }
            }
        } else if (sub == 6) {
            const int hd = tid & 15, seg = tid >> 4;
            const float a = -__expf(alog[hd]), db = dtb[hd];
            float sp[8], cum = 0.f;
#pragma unroll
            for (int j = 0; j < 8; ++j) {
                const float v = DT[(size_t)(t0 + seg * 8 + j) * 16 + hd] + db;
                sp[j] = v > 20.f ? v : log1pf(expf(v));
                cum += sp[j] * a;
            }
            sseg[seg * 16 + hd] = cum;
            __syncthreads();
            float base = 0.f;
            for (int s2 = 0; s2 < seg; ++s2) base += sseg[s2 * 16 + hd];
            cum = base;
#pragma unroll
            for (int j = 0; j < 8; ++j) {
                cum += sp[j] * a;
                DTV[(size_t)(t0 + seg * 8 + j) * 16 + hd] = sp[j];
                ACS[(size_t)(t0 + seg * 8 + j) * 16 + hd] = cum;
            }
            __syncthreads();
        } else {
            const int ch = (sub - 7) * 256 + tid, g = ch >> 7, w = 2 << g;
            float s = 0.f;
            for (int j = 1; j < w; ++j) if (pos0 - j >= 0) s += bf2f(U[(size_t)(t0 - j) * 512 + ch]);
            for (int l0 = 0; l0 < 128; l0 += 32) {
                float cu[32], old[32];
#pragma unroll
                for (int j = 0; j < 32; ++j) {
                    cu[j] = bf2f(U[(size_t)(t0 + l0 + j) * 512 + ch]);
                    const int po = pos0 + l0 + j - w + 1;
                    old[j] = po >= 0 ? bf2f(U[(size_t)(t0 + l0 + j - w + 1) * 512 + ch]) : 0.f;
                }
#pragma unroll
                for (int j = 0; j < 32; ++j) {
                    const int pos = pos0 + l0 + j;
                    s += cu[j];
                    const int cnt = pos + 1 < w ? pos + 1 : w;
                    DIFF[(size_t)(t0 + l0 + j) * 512 + ch] = f2bf(s / (float)cnt - cu[j]);
                    s -= old[j];
                }
            }
        }
    }
}

DI void phase_even_states(const Ctx& cx, const P& p, unsigned char* smem, int li) {
    unsigned char* R = p.ws + OFF_R;
    const float* DTV = (const float*)(R + RE_DTV); const float* ACS = (const float*)(R + RE_ACS);
    const bf16_t* BT = (const bf16_t*)(R + RE_BT); const bf16_t* XST = (const bf16_t*)(R + RE_XST);
    bf16_t* ST = (bf16_t*)(p.ws + OFF_XB);
    const int tid = cx.tid, lane = tid & 63, w = __builtin_amdgcn_readfirstlane(tid >> 6), r = lane & 31, h = lane >> 5;
    float* wsc = (float*)smem;
    for (int u = cx.bid; u < 2048; u += cx.nb) {
        const int H = u & 15, c = (u >> 4) & 63, b = u >> 10, g = H >> 3, t0 = b * S_ + c * 128, pos0 = c * 128;
        if (tid < 128) wsc[tid] = DTV[(size_t)(t0 + tid) * 16 + H] * __expf(ACS[(size_t)(t0 + 127) * 16 + H] - ACS[(size_t)(t0 + tid) * 16 + H]);
        __syncthreads();
        f32x16 acc[2] = {zero16(), zero16()};
        const int n0 = 32 * w;
#pragma unroll
        for (int st = 0; st < 8; ++st) {
            const int kb = 16 * st + 8 * h;
            const bf16x8 bf = *(const bf16x8*)(BT + ((size_t)b * 256 + g * 128 + n0 + r) * S_ + pos0 + kb);
            const f32x4 wa = *(const f32x4*)(wsc + kb), wb = *(const f32x4*)(wsc + kb + 4);
#pragma unroll
            for (int pt = 0; pt < 2; ++pt) {
                const u32x4 raw = *(const u32x4*)(XST + ((size_t)b * 1024 + H * 64 + 32 * pt + r) * S_ + pos0 + kb);
                u32x4 sc;
                sc.x = pk2(bflo(raw.x) * wa[0], bfhi(raw.x) * wa[1]); sc.y = pk2(bflo(raw.y) * wa[2], bfhi(raw.y) * wa[3]);
                sc.z = pk2(bflo(raw.z) * wb[0], bfhi(raw.z) * wb[1]); sc.w = pk2(bflo(raw.w) * wb[2], bfhi(raw.w) * wb[3]);
                acc[pt] = mfma32(__builtin_bit_cast(bf16x8, sc), bf, acc[pt]);
            }
        }
#pragma unroll
        for (int pt = 0; pt < 2; ++pt)
#pragma unroll
            for (int i = 0; i < 16; ++i)
                ST[((((size_t)b * 64 + c) * 16 + H) * 64 + 32 * pt + crow(i, h)) * 128 + n0 + r] = f2bf(acc[pt][i]);
        __syncthreads();
    }
    {
        const bf16_t* DIFF = (const bf16_t*)(R + RE_DIFF); bf16_t* YC = (bf16_t*)(R + RE_XBC);
        const bf16_t* PW = (const bf16_t*)(p.ws + OFF_WM) + WE_POOL;
        const float* psc = p.pool_scale + li * 512;
        for (int t = cx.bid; t < 512; t += cx.nb) {
            const int g = t & 3, mt = t >> 2;
            auto epi = [=](auto& acc, int mb, int nb, int lane2) {
                epi_each(acc, mb, nb, lane2, [=](int row, int col, float v) { YC[(size_t)row * 1536 + 1024 + g * 128 + col] = f2bf(v * psc[g * 128 + col]); });
            };
            gemm_tile<2, false>(cx, smem, DIFF + g * 128, 512, PW + (size_t)g * 128 * 128, 128, 128, mt * 128, 0, epi, NoHook(), -1);
        }
    }
}

DI void phase_even_scan(const Ctx& cx, const P& p) {
    unsigned char* R = p.ws + OFF_R;
    const float* ACS = (const float*)(R + RE_ACS);
    bf16_t* ST = (bf16_t*)(p.ws + OFF_XB);
    for (int e = cx.bid * 256 + cx.tid; e < 262144; e += cx.nb * 256) {
        const int n = e & 127, pp = (e >> 7) & 63, H = (e >> 13) & 15, b = e >> 17;
        float hst = 0.f;
        bf16_t* sp = ST + (((size_t)b * 64 * 16 + H) * 64 + pp) * 128 + n;
        const float* ap = ACS + (size_t)(b * S_ + 127) * 16 + H;
#pragma unroll 1
        for (int c0 = 0; c0 < 64; c0 += 16) {
            float st[16], dec[16];
#pragma unroll
            for (int j = 0; j < 16; ++j) { st[j] = bf2f(sp[(size_t)(c0 + j) * (16 * 64 * 128)]); dec[j] = ap[(size_t)(c0 + j) * (128 * 16)]; }
#pragma unroll
            for (int j = 0; j < 16; ++j) {
                sp[(size_t)(c0 + j) * (16 * 64 * 128)] = f2bf(hst);
                hst = hst * __expf(dec[j]) + st[j];
            }
        }
    }
}

DI void phase_even_y(const Ctx& cx, const P& p, unsigned char* smem, int li, int layer) {
    unsigned char* R = p.ws + OFF_R;
    const float* DTV = (const float*)(R + RE_DTV); const float* ACS = (const float*)(R + RE_ACS);
    const bf16_t* BN = (const bf16_t*)(R + RE_BN); const bf16_t* CN = (const bf16_t*)(R + RE_CN); const bf16_t* XST = (const bf16_t*)(R + RE_XST);
    const bf16_t* Z = (const bf16_t*)(R + RE_Z); bf16_t* YC = (bf16_t*)(R + RE_XBC);
    const bf16_t* PREV = (const bf16_t*)(p.ws + OFF_XB);
    float* SSQ = (float*)(p.ws + OFF_MISC + MISC_SSQ) + (size_t)layer * 2 * T_;
    const float* dsk = p.d_skip + li * 16; const float* nw = p.ssm_norm_w + li * 1024;
    const int tid = cx.tid, lane = tid & 63, w = __builtin_amdgcn_readfirstlane(tid >> 6), r = lane & 31, h = lane >> 5;
    float* sacs = (float*)smem;
    float* sdtv = sacs + 512;
    for (int u = cx.bid; u < 512; u += cx.nb) {
        const int hh = u & 1, g = (u >> 1) & 1, c = (u >> 2) & 63, b = u >> 8, t0 = b * S_ + c * 128, pos0 = c * 128, l0 = 32 * w;
        for (int idx = tid; idx < 512; idx += 256) {
            const int k = idx >> 7, l = idx & 127, H = g * 8 + hh * 4 + k;
            sacs[idx] = ACS[(size_t)(t0 + l) * 16 + H]; sdtv[idx] = DTV[(size_t)(t0 + l) * 16 + H];
        }
        __syncthreads();
        const bf16_t* crow_p = CN + (size_t)(t0 + l0 + r) * 256 + g * 128 + 8 * h;
        u32x4* xl = (u32x4*)(smem + 4096) + w * 512;
#pragma unroll 1
        for (int st = 0; st <= w; ++st) {
            f32x16 xt = zero16();
            const bf16_t* brow_p = BN + (size_t)(t0 + 32 * st + r) * 256 + g * 128 + 8 * h;
#pragma unroll
            for (int k = 0; k < 8; ++k) xt = mfma32(*(const bf16x8*)(brow_p + 16 * k), *(const bf16x8*)(crow_p + 16 * k), xt);
            xl[(st * 2 + 0) * 64 + lane] = __builtin_bit_cast(u32x4, pack8<0>(xt));
            xl[(st * 2 + 1) * 64 + lane] = __builtin_bit_cast(u32x4, pack8<1>(xt));
        }
        float ssq[16];
#pragma unroll
        for (int i = 0; i < 16; ++i) ssq[i] = 0.f;
#pragma unroll 1
        for (int k = 0; k < 4; ++k) {
            const int H = g * 8 + hh * 4 + k;
            const float acs_l = sacs[k * 128 + l0 + r], Dk = dsk[H];
            const bf16_t* xrow0 = XST + ((size_t)b * 1024 + H * 64 + r) * S_ + pos0;
            f32x16 yd0 = zero16(), yd1 = zero16(), yo0 = zero16(), yo1 = zero16();
#pragma unroll 1
            for (int st = 0; st <= w; ++st) {
                const u32x4 x0 = xl[(st * 2 + 0) * 64 + lane], x1 = xl[(st * 2 + 1) * 64 + lane];
                f32x16 m;
#pragma unroll
                for (int i4 = 0; i4 < 4; ++i4) {
                    const f32x4 as4 = *(const f32x4*)(sacs + k * 128 + 32 * st + 8 * i4 + 4 * h);
                    const f32x4 dt4 = *(const f32x4*)(sdtv + k * 128 + 32 * st + 8 * i4 + 4 * h);
#pragma unroll
                    for (int j = 0; j < 4; ++j) {
                        const int sl = 8 * i4 + 4 * h + j;
                        const bool valid = (st < w) || (sl <= r);
                        const float e = valid ? __expf(acs_l - as4[j]) * dt4[j] : 0.f;
                        const unsigned xw = (i4 >> 1) ? x1[2 * (i4 & 1) + (j >> 1)] : x0[2 * (i4 & 1) + (j >> 1)];
                        m[4 * i4 + j] = ((j & 1) ? bfhi(xw) : bflo(xw)) * e;
                    }
                }
                const bf16x8 pa0 = pack8<0>(m), pa1 = pack8<1>(m);
                const bf16_t* xb0 = xrow0 + 32 * st + 4 * h;
                {
                    u32x4 f0, f1;
                    const u32x2 a0 = *(const u32x2*)(xb0), a1 = *(const u32x2*)(xb0 + 8), a2 = *(const u32x2*)(xb0 + 16), a3 = *(const u32x2*)(xb0 + 24);
                    f0.x = a0.x; f0.y = a0.y; f0.z = a1.x; f0.w = a1.y; f1.x = a2.x; f1.y = a2.y; f1.z = a3.x; f1.w = a3.y;
                    yd0 = mfma32(pa0, __builtin_bit_cast(bf16x8, f0), yd0);
                    yd0 = mfma32(pa1, __builtin_bit_cast(bf16x8, f1), yd0);
                }
                {
                    const bf16_t* xb1 = xb0 + (size_t)32 * S_;
                    u32x4 f0, f1;
                    const u32x2 a0 = *(const u32x2*)(xb1), a1 = *(const u32x2*)(xb1 + 8), a2 = *(const u32x2*)(xb1 + 16), a3 = *(const u32x2*)(xb1 + 24);
                    f0.x = a0.x; f0.y = a0.y; f0.z = a1.x; f0.w = a1.y; f1.x = a2.x; f1.y = a2.y; f1.z = a3.x; f1.w = a3.y;
                    yd1 = mfma32(pa0, __builtin_bit_cast(bf16x8, f0), yd1);
                    yd1 = mfma32(pa1, __builtin_bit_cast(bf16x8, f1), yd1);
                }
            }
            const bf16_t* prow = PREV + ((((size_t)b * 64 + c) * 16 + H) * 64 + r) * 128 + 8 * h;
#pragma unroll 2
            for (int kk = 0; kk < 8; ++kk) {
                const bf16x8 cf = *(const bf16x8*)(crow_p + 16 * kk);
                yo0 = mfma32(cf, *(const bf16x8*)(prow + 16 * kk), yo0);
                yo1 = mfma32(cf, *(const bf16x8*)(prow + 32 * 128 + 16 * kk), yo1);
            }
            {
                const int col = H * 64 + r;
                const float nw0 = nw[col], nw1 = nw[col + 32];
                const bf16_t* zp = Z + (size_t)(t0 + l0 + 4 * h) * 1024 + col;
                bf16_t* yp = YC + (size_t)(t0 + l0 + 4 * h) * 1536 + col;
                const bf16_t* xp = xrow0 + l0 + 4 * h;
                const float* eap = sacs + k * 128 + l0 + 4 * h;
#pragma unroll
                for (int i4 = 0; i4 < 4; ++i4) {
                    asm volatile("" : "+v"(zp), "+v"(yp), "+v"(xp));
                    const f32x4 ea = *(const f32x4*)(eap + 8 * i4);
                    typedef const __attribute__((address_space(1))) bf16_t* gcp; typedef __attribute__((address_space(1))) bf16_t* gwp;
                    typedef const __attribute__((address_space(1))) u32x2* gcp2;
                    const gcp zg = (gcp)(unsigned long long)zp; const gwp yg_ = (gwp)(unsigned long long)yp;
                    const u32x2 xa = *(gcp2)(unsigned long long)(xp), xb = *(gcp2)(unsigned long long)(xp + (size_t)32 * S_);
#pragma unroll
                    for (int j = 0; j < 4; ++j) {
                        const int i = 4 * i4 + j;
                        const float ee = __expf(ea[j]);
                        const float xs0 = j == 0 ? bflo(xa.x) : (j == 1 ? bfhi(xa.x) : (j == 2 ? bflo(xa.y) : bfhi(xa.y)));
                        const float xs1 = j == 0 ? bflo(xb.x) : (j == 1 ? bfhi(xb.x) : (j == 2 ? bflo(xb.y) : bfhi(xb.y)));
                        const float y0 = yd0[i] + ee * yo0[i] + Dk * xs0, y1 = yd1[i] + ee * yo1[i] + Dk * xs1;
                        const float g0 = y0 * silu_f(bf2f(zg[j * 1024])), g1 = y1 * silu_f(bf2f(zg[j * 1024 + 32]));
                        ssq[i] += g0 * g0 + g1 * g1;
                        yg_[j * 1536] = f2bf(g0 * nw0); yg_[j * 1536 + 32] = f2bf(g1 * nw1);
                    }
                    zp += 8 * 1024; yp += 8 * 1536; xp += 8;
                }
            }
        }
#pragma unroll
        for (int i = 0; i < 16; ++i) {
            float s = ssq[i];
            s += __shfl_xor(s, 1); s += __shfl_xor(s, 2); s += __shfl_xor(s, 4); s += __shfl_xor(s, 8); s += __shfl_xor(s, 16);
            if (r == 0) atomicAdd(SSQ + t0 + l0 + crow(i, h), s);
        }
        __syncthreads();
    }
}

DI void phase_even_out(const Ctx& cx, const P& p, unsigned char* smem, int layer) {
    const float* SSQ = (const float*)(p.ws + OFF_MISC + MISC_SSQ) + (size_t)layer * 2 * T_;
    auto hook = [=](auto& acc, int mb, int lane) {
        const int h = lane >> 5;
#pragma unroll
        for (int mt = 0; mt < 2; ++mt)
#pragma unroll
            for (int i4 = 0; i4 < 4; ++i4) {
                unsigned ri = (unsigned)(mb + 32 * mt + 8 * i4 + 4 * h);
                asm volatile("" : "+v"(ri));
                const f32x4 q4 = *(const f32x4*)(SSQ + ri);
#pragma unroll
                for (int j = 0; j < 4; ++j) {
                    const float rs = 1.0f / sqrtf(q4[j] * (1.f / 1024.f) + 1e-6f);
#pragma unroll
                    for (int nt = 0; nt < (int)(sizeof(acc[0]) / sizeof(f32x16)); ++nt) acc[mt][nt][4 * i4 + j] *= rs;
                }
            }
    };
    const EpiResidLN epi = make_ln_epi(cx, p, smem, layer, 0);
    gemm_phase<true, false>(cx, smem, (const bf16_t*)(p.ws + OFF_R + RE_XBC), 1536, (const bf16_t*)(p.ws + OFF_WM) + WE_OUT, 1536, 1536, T_, 1024, epi, hook, 15);
}

DI void phase_odd_in(const Ctx& cx, const P& p, unsigned char* smem, int layer) {
    unsigned char* R = p.ws + OFF_R;
    bf16_t* QF = (bf16_t*)(R + RO_QF); bf16_t* KF = (bf16_t*)(R + RO_KF); bf16_t* VF = (bf16_t*)(R + RO_VF); bf16_t* CQ = (bf16_t*)(R + RO_CQ);
    bf16_t* CKV = (bf16_t*)(R + RO_CKV); bf16_t* KR = (bf16_t*)(R + RO_KR); float* FL = (float*)(R + RO_FL);
    float* SSQ = (float*)(p.ws + OFF_MISC + MISC_SSQ) + (size_t)layer * 2 * T_;
    const f32x2* rope = (const f32x2*)(p.ws + OFF_MISC + MISC_ROPE);
    auto tile = [=](const f32x16& a0, const f32x16& a1, int mb, int cb, int lane) {
        const int h = lane >> 5, c = lane & 31, col = cb + c;
#pragma unroll
        for (int mt = 0; mt < 2; ++mt)
#pragma unroll
            for (int i4 = 0; i4 < 4; ++i4) {
                int rb = mb + 32 * mt + 8 * i4 + 4 * h;
                asm volatile("" : "+v"(rb));
#pragma unroll
                for (int j = 0; j < 4; ++j) {
                    const int row = rb + j;
                    const float v = mt == 0 ? a0[4 * i4 + j] : a1[4 * i4 + j];
                    if (cb < 1536) {
                        bf16_t* dst = QF + (size_t)(cb >> 9) * (8u << 20);
                        dst[(size_t)row * 512 + (col & 511)] = f2bf(cb < 512 ? v * QS_FOX : v);
                    } else if (cb < 2304) {
                        const bool isq = cb < 2048;
                        if (isq) CQ[(size_t)row * 512 + col - 1536] = f2bf(v); else CKV[(size_t)row * 256 + col - 2048] = f2bf(v);
                        float s = v * v;
                        s += __shfl_xor(s, 1); s += __shfl_xor(s, 2); s += __shfl_xor(s, 4); s += __shfl_xor(s, 8); s += __shfl_xor(s, 16);
                        if (c == 0) atomicAdd(SSQ + (isq ? 0 : T_) + row, s);
                    } else if (cb == 2304) {
                        const float o = __shfl_xor(v, 16);
                        const f32x2 cs = rope[(size_t)(row & (S_ - 1)) * 16 + (c & 15)];
                        KR[(size_t)row * 32 + c] = f2bf((c < 16) ? (v * cs.x - o * cs.y) : (v * cs.x + o * cs.y));
                    } else if (cb == 2336) {
                        if (c < 8) FL[(size_t)row * 8 + c] = v;
                    }
                }
            }
    };
    auto epi = [=](auto& acc, int mb, int nb, int lane) {
#pragma unroll
        for (int nt = 0; nt < (int)(sizeof(acc[0]) / sizeof(f32x16)); ++nt) tile(acc[0][nt], acc[1][nt], mb, nb + 32 * nt, lane);
    };
    gemm_phase<false, true, true, true>(cx, smem, (const bf16_t*)(p.ws + OFF_XB), 1024, (const bf16_t*)(p.ws + OFF_WM) + WO_IN, 1024, 1024, T_, 2432, epi, NoHook(), -1);
}

DI float logsig(float x) { return fminf(x, 0.f) - log1pf(expf(-fabsf(x))); }

DI void phase_odd_qkv(const Ctx& cx, const P& p, unsigned char* smem, int li, int layer) {
    unsigned char* R = p.ws + OFF_R;
    const bf16_t* CQ = (const bf16_t*)(R + RO_CQ); const bf16_t* CKV = (const bf16_t*)(R + RO_CKV);
    bf16_t* QM = (bf16_t*)(R + RO_QM); bf16_t* KN = (bf16_t*)(R + RO_KN); bf16_t* VM = (bf16_t*)(R + RO_VM);
    const float* FL = (const float*)(R + RO_FL); float* FC = (float*)(R + RO_FC);
    const float* SSQ = (const float*)(p.ws + OFF_MISC + MISC_SSQ) + (size_t)layer * 2 * T_;
    const f32x2* rope = (const f32x2*)(p.ws + OFF_MISC + MISC_ROPE);
    const bf16_t* wm = (const bf16_t*)(p.ws + OFF_WM);
    if (cx.bid >= cx.nb - 16) {
        const float* fb = p.fgate_b + li * 8;
        double* sd = (double*)smem;
        const int tid = cx.tid, u = cx.bid - (cx.nb - 16);
        const int b = u >> 3, hd = u & 7;
        const float bias = fb[hd];
        float loc = 0.f;
        for (int j = 0; j < 32; ++j) loc += logsig(FL[(size_t)(b * S_ + tid * 32 + j) * 8 + hd] + bias);
        sd[tid] = (double)loc;
        __syncthreads();
        double base = 0.0;
        for (int j = 0; j < tid; ++j) base += sd[j];
        float run = 0.f;
        for (int j = 0; j < 32; ++j) {
            run += logsig(FL[(size_t)(b * S_ + tid * 32 + j) * 8 + hd] + bias);
            FC[((size_t)b * 8 + hd) * S_ + tid * 32 + j] = (float)((base + (double)run) * (double)LOG2E);
        }
        __syncthreads();
    }
    auto epiq = [=](auto& acc, int mb, int nb, int lane) {
        constexpr int NT = sizeof(acc[0]) / sizeof(f32x16);
        const int h = lane >> 5, c = lane & 31;
#pragma unroll
        for (int mt = 0; mt < 2; ++mt)
#pragma unroll
            for (int i4 = 0; i4 < 4; ++i4) {
                int rb = mb + 32 * mt + 8 * i4 + 4 * h;
                asm volatile("" : "+v"(rb));
#pragma unroll
                for (int j = 0; j < 4; ++j) {
                    const int row = rb + j;
                    const float rs = 1.0f / sqrtf(SSQ[row] * (1.f / 512.f) + 1e-6f);
                    const f32x2 cs = rope[(size_t)(row & (S_ - 1)) * 16 + (c & 15)];
#pragma unroll
                    for (int nt = 0; nt < NT; ++nt) {
                        const int cb = nb + 32 * nt;
                        float v = acc[mt][nt][4 * i4 + j] * rs;
                        if ((cb % 96) >= 64) {
                            const float o = __shfl_xor(v, 16);
                            v = (c < 16) ? (v * cs.x - o * cs.y) : (v * cs.x + o * cs.y);
                        }
                        QM[(size_t)row * 768 + cb + c] = f2bf(v * QS_MLA);
                    }
                }
            }
    };
    gemm_phase<false, false, false>(cx, smem, CQ, 512, wm + WO_UQ, 512, 512, T_, 768, epiq, NoHook(), -1);
    auto epikv = [=](auto& acc, int mb, int nb, int lane) {
        epi_each(acc, mb, nb, lane, [=](int row, int col, float v) {
            const float rs = 1.0f / sqrtf(SSQ[T_ + row] * (1.f / 256.f) + 1e-6f);
            const int hd = col >> 7, j = col & 127;
            if (j < 64) KN[(size_t)row * 512 + hd * 64 + j] = f2bf(v * rs); else VM[(size_t)row * 512 + hd * 64 + j - 64] = f2bf(v * rs);
        });
    };
    gemm_phase<false, false, false>(cx, smem, CKV, 256, wm + WO_UKV, 256, 256, T_, 1024, epikv, NoHook(), -1);
    {
        const bf16_t* QF = (const bf16_t*)(R + RO_QF); const bf16_t* KF = (const bf16_t*)(R + RO_KF);
        unsigned* NRM = (unsigned*)(p.ws + OFF_MISC + MISC_NRM) + layer * 32;
        for (int idx = cx.bid * 256 + cx.tid; idx < T_ * 8; idx += cx.nb * 256) {
            const int row = idx >> 3, hd = idx & 7, b = row >> 13;
            float sq = 0.f, sk = 0.f;
#pragma unroll
            for (int j = 0; j < 8; ++j) {
                const u32x4 a = *(const u32x4*)(QF + (size_t)row * 512 + hd * 64 + 8 * j), c = *(const u32x4*)(KF + (size_t)row * 512 + hd * 64 + 8 * j);
#pragma unroll
                for (int e = 0; e < 4; ++e) { const float a0 = bflo(a[e]), a1 = bfhi(a[e]), c0 = bflo(c[e]), c1 = bfhi(c[e]); sq += a0 * a0 + a1 * a1; sk += c0 * c0 + c1 * c1; }
            }
            sq = fmaxf(sq, __shfl_xor(sq, 8)); sq = fmaxf(sq, __shfl_xor(sq, 16)); sq = fmaxf(sq, __shfl_xor(sq, 32));
            sk = fmaxf(sk, __shfl_xor(sk, 8)); sk = fmaxf(sk, __shfl_xor(sk, 16)); sk = fmaxf(sk, __shfl_xor(sk, 32));
            if ((cx.tid & 63) < 8) { atomicMax(NRM + (b * 8 + hd) * 2, __float_as_uint(sq)); atomicMax(NRM + (b * 8 + hd) * 2 + 1, __float_as_uint(sk)); }
        }
    }
}

DI void phase_attn(const Ctx& cx, const P& p, unsigned char* smem, int cidx) {
    unsigned char* R = p.ws + OFF_R;
    const bf16_t* QF = (const bf16_t*)(R + RO_QF); const bf16_t* KF = (const bf16_t*)(R + RO_KF); const bf16_t* VF = (const bf16_t*)(R + RO_VF);
    const bf16_t* QM = (const bf16_t*)(R + RO_QM); const bf16_t* KN = (const bf16_t*)(R + RO_KN); const bf16_t* VM = (const bf16_t*)(R + RO_VM);
    const bf16_t* KR = (const bf16_t*)(R + RO_KR); const float* FC = (const float*)(R + RO_FC); bf16_t* OC = (bf16_t*)(R + RO_OCAT);
    int* cnt = (int*)(p.ws + OFF_MISC + MISC_CNT) + cidx;
    const int tid = cx.tid, lane = tid & 63, w = __builtin_amdgcn_readfirstlane(tid >> 6), r = lane & 31, h = lane >> 5;
    constexpr int KST = 104, VST = 72;
    constexpr int STAGE = 64 * KST * 2 + 64 * VST * 2 + 256;
    int* s_unit = (int*)(smem + 2 * STAGE);
    int* s_kt0 = s_unit + 1;
    const unsigned* NRM = (const unsigned*)(p.ws + OFF_MISC + MISC_NRM) + (cidx & 3) * 32;
    for (;;) {
        if (tid == 0) *s_unit = atomicAdd(cnt, 1);
        __syncthreads();
        const int u = *s_unit;
        __syncthreads();
        if (u >= 2048) break;
        const int qb = 63 - (u >> 5), rr = u & 31, kind = rr >> 4, b = (rr >> 3) & 1, hd = rr & 7;
        const bool fox = kind == 1;
        const int q0 = qb * 128, qrow0 = q0 + 32 * w, nkt = 2 * qb + 2;
        const size_t tb = (size_t)b * S_;
        const bf16_t* Kb = fox ? KF : KN; const bf16_t* Vb = fox ? VF : VM;
        const int cpr = fox ? 8 : 12, npiece = 64 * cpr;
        bf16x8 qf[6];
#pragma unroll
        for (int k = 0; k < 6; ++k) {
            if (fox) { if (k < 4) qf[k] = *(const bf16x8*)(QF + (tb + qrow0 + r) * 512 + hd * 64 + 16 * k + 8 * h); else qf[k] = (bf16x8){0, 0, 0, 0, 0, 0, 0, 0}; }
            else qf[k] = *(const bf16x8*)(QM + (tb + qrow0 + r) * 768 + hd * 96 + 16 * k + 8 * h);
        }
        int kt0 = 0;
        if (fox) {
            const float bnd = sqrtf(__uint_as_float(NRM[(b * 8 + hd) * 2]) * __uint_as_float(NRM[(b * 8 + hd) * 2 + 1])) * 1.01f;
            const float thr = -(2.f * bnd + 40.f);
            const float* fc = FC + ((size_t)b * 8 + hd) * S_;
            const float fq0 = fc[q0];
            if (tid == 0) *s_kt0 = nkt - 1;
            __syncthreads();
            if (tid < nkt) { if (!(fq0 - fc[tid * 64 + 63] < thr)) atomicMin(s_kt0, tid); }
            __syncthreads();
            kt0 = *s_kt0;
        }
        f32x16 O[2] = {zero16(), zero16()};
        float mrun = -INFINITY, lsum = 0.f;
        u32x4 rk[3], rv[2]; float rfk = 0.f;
        auto gload = [&](int kt) {
            const size_t kbase = tb + (size_t)kt * 64;
#pragma unroll
            for (int i = 0; i < 3; ++i) {
                const int pc = tid + 256 * i;
                if (pc < npiece) {
                    const int row = pc / cpr, ch = pc - row * cpr;
                    rk[i] = ch < 8 ? *(const u32x4*)(Kb + (kbase + row) * 512 + hd * 64 + ch * 8) : *(const u32x4*)(KR + (kbase + row) * 32 + (ch - 8) * 8);
                }
            }
#pragma unroll
            for (int i = 0; i < 2; ++i) { const int pc = tid + 256 * i, row = pc >> 3, ch = pc & 7; rv[i] = *(const u32x4*)(Vb + (kbase + row) * 512 + hd * 64 + ch * 8); }
            if (fox && tid < 64) rfk = FC[((size_t)b * 8 + hd) * S_ + kt * 64 + tid];
        };
        auto lstore = [&](int st) {
            bf16_t* Ks = (bf16_t*)(smem + st * STAGE); bf16_t* Vs = Ks + 64 * KST; float* fks = (float*)(Vs + 64 * VST);
#pragma unroll
            for (int i = 0; i < 3; ++i) { const int pc = tid + 256 * i; if (pc < npiece) { const int row = pc / cpr, ch = pc - row * cpr; *(u32x4*)(Ks + row * KST + ch * 8) = rk[i]; } }
#pragma unroll
            for (int i = 0; i < 2; ++i) { const int pc = tid + 256 * i, row = pc >> 3, ch = pc & 7; *(u32x4*)(Vs + row * VST + ch * 8) = rv[i]; }
            if (fox && tid < 64) fks[tid] = rfk;
        };
        auto compute = [&](auto foxc, const bf16_t* Ks, const bf16_t* Vs, const float* fks, int kt) {
            constexpr bool FOX = decltype(foxc)::value;
            constexpr int NK = FOX ? 4 : 6;
            f32x16 s[2] = {zero16(), zero16()};
            {
                const bf16_t* kb = Ks + r * KST + 8 * h;
                bf16x8 kc = *(const bf16x8*)(kb);
#pragma unroll
                for (int step = 0; step < 2 * NK; ++step) {
                    bf16x8 kn = kc;
                    if (step + 1 < 2 * NK) kn = *(const bf16x8*)(kb + ((step + 1) / NK) * 32 * KST + ((step + 1) % NK) * 16);
                    __builtin_amdgcn_sched_barrier(0);
                    s[step / NK] = mfma32(kc, qf[step % NK], s[step / NK]);
                    kc = kn;
                }
            }
            const int q4 = (lane & 15) >> 2, p4 = lane & 3, blk = (lane >> 4) & 1;
            const bf16_t* vbase = Vs + (4 * h + q4) * VST + 16 * blk + 4 * p4;
            auto ldv = [&](int idx) -> bf16x8 {
                const bf16_t* va = vbase + (32 * (idx >> 2) + 16 * (idx & 1)) * VST + 32 * ((idx >> 1) & 1);
                const s16x4 lo = __builtin_amdgcn_ds_read_tr16_b64_v4i16((__attribute__((address_space(3))) s16x4*)(va));
                const s16x4 hi = __builtin_amdgcn_ds_read_tr16_b64_v4i16((__attribute__((address_space(3))) s16x4*)(va + 8 * VST));
                return __builtin_shufflevector(lo, hi, 0, 1, 2, 3, 4, 5, 6, 7);
            };
            if (FOX) {
#pragma unroll
                for (int st = 0; st < 2; ++st)
#pragma unroll
                    for (int i4 = 0; i4 < 4; ++i4) {
                        const f32x4 fk4 = *(const f32x4*)(fks + 32 * st + 8 * i4 + 4 * h);
#pragma unroll
                        for (int j = 0; j < 4; ++j) s[st][4 * i4 + j] -= fk4[j];
                    }
            }
            if (kt * 64 + 63 > qrow0) {
                asm volatile("" ::: "memory");
                const int qpos = qrow0 + r;
#pragma unroll
                for (int st = 0; st < 2; ++st)
#pragma unroll
                    for (int i = 0; i < 16; ++i) { const int key = kt * 64 + 32 * st + crow(i, h); if (key > qpos) s[st][i] = -INFINITY; }
            }
            float mx = -INFINITY;
#pragma unroll
            for (int st = 0; st < 2; ++st)
#pragma unroll
                for (int i = 0; i < 16; ++i) mx = fmaxf(mx, s[st][i]);
            mx = fmaxf(mx, __shfl_xor(mx, 32));
            const float mnew = fmaxf(mrun, mx);
            if (__builtin_amdgcn_ballot_w64(mnew > mrun)) {
                const float alpha = __builtin_amdgcn_exp2f(mrun - mnew);
                lsum *= alpha;
#pragma unroll
                for (int dt = 0; dt < 2; ++dt)
#pragma unroll
                    for (int i = 0; i < 16; ++i) O[dt][i] *= alpha;
                mrun = mnew;
            }
            float ps = 0.f;
#pragma unroll
            for (int st = 0; st < 2; ++st)
#pragma unroll
                for (int i = 0; i < 16; ++i) { const float pv = __builtin_amdgcn_exp2f(s[st][i] - mnew); s[st][i] = pv; ps += pv; }
            lsum += ps;
            const bf16x8 pb[4] = {pack8<0>(s[0]), pack8<1>(s[0]), pack8<0>(s[1]), pack8<1>(s[1])};
            bf16x8 vc = ldv(0);
#pragma unroll
            for (int idx = 0; idx < 8; ++idx) {
                bf16x8 vn = vc;
                if (idx + 1 < 8) vn = ldv(idx + 1);
                __builtin_amdgcn_sched_barrier(0);
                O[(idx >> 1) & 1] = mfma32(vc, pb[(idx >> 2) * 2 + (idx & 1)], O[(idx >> 1) & 1]);
                vc = vn;
            }
        };
        gload(kt0); lstore(0);
        __syncthreads();
        for (int kt = kt0; kt < nkt; ++kt) {
            const int cur = (kt - kt0) & 1;
            if (kt + 1 < nkt) gload(kt + 1);
            if (kt * 64 <= qrow0 + 31) {
                const bf16_t* Ks = (const bf16_t*)(smem + cur * STAGE); const bf16_t* Vs = Ks + 64 * KST; const float* fks = (const float*)(Vs + 64 * VST);
                if (fox) compute(std::integral_constant<bool, true>(), Ks, Vs, fks, kt);
                else compute(std::integral_constant<bool, false>(), Ks, Vs, fks, kt);
            }
            if (kt + 1 < nkt) lstore(cur ^ 1);
            __syncthreads();
        }
        const float lt = lsum + __shfl_xor(lsum, 32);
        const float inv = 1.0f / lt;
        bf16_t* orow = OC + (tb + qrow0 + r) * 1024 + (fox ? 0 : 512) + hd * 64;
#pragma unroll
        for (int dt = 0; dt < 2; ++dt)
#pragma unroll
            for (int i4 = 0; i4 < 4; ++i4) {
                u32x2 o; o.x = pk2(O[dt][4 * i4] * inv, O[dt][4 * i4 + 1] * inv); o.y = pk2(O[dt][4 * i4 + 2] * inv, O[dt][4 * i4 + 3] * inv);
                *(u32x2*)(orow + 32 * dt + 8 * i4 + 4 * h) = o;
            }
    }
}

DI void phase_odd_out(const Ctx& cx, const P& p, unsigned char* smem, int layer) {
    const EpiResidLN epi = make_ln_epi(cx, p, smem, layer, 0);
    gemm_phase<false, false>(cx, smem, (const bf16_t*)(p.ws + OFF_R + RO_OCAT), 1024, (const bf16_t*)(p.ws + OFF_WM) + WO_OUT, 1024, 1024, T_, 1024, epi, NoHook(), -1);
}

constexpr int N_PHASES = 29;
DI void run_phase(const Ctx& cx, const P& p_in, int ph, unsigned char* smem) {
    P p = p_in;
    { unsigned long long* q_ = (unsigned long long*)&p;
#pragma unroll
      for (int i_ = 0; i_ < 27; ++i_) asm volatile("" : "+s"(q_[i_])); }
#define AS_GLOBAL(m) p.m = (decltype(p.m))(__attribute__((address_space(1))) unsigned char*)(unsigned long long)p.m
    AS_GLOBAL(x); AS_GLOBAL(even_w_in); AS_GLOBAL(pool_w); AS_GLOBAL(pool_scale); AS_GLOBAL(conv_w); AS_GLOBAL(conv_b); AS_GLOBAL(dt_bias); AS_GLOBAL(a_log);
    AS_GLOBAL(d_skip); AS_GLOBAL(ssm_norm_w); AS_GLOBAL(even_w_out); AS_GLOBAL(odd_w_in); AS_GLOBAL(fgate_b); AS_GLOBAL(q_norm_w); AS_GLOBAL(w_uq); AS_GLOBAL(kv_norm_w);
    AS_GLOBAL(w_ukv); AS_GLOBAL(odd_w_out); AS_GLOBAL(ffn_w_gate); AS_GLOBAL(ffn_w_up); AS_GLOBAL(ffn_w_down); AS_GLOBAL(ln_mix_g); AS_GLOBAL(ln_mix_b); AS_GLOBAL(ln_ffn_g);
    AS_GLOBAL(ln_ffn_b); AS_GLOBAL(out); AS_GLOBAL(ws);
#undef AS_GLOBAL
    if (ph == 0) { phase_prep(cx, p, smem); return; }
    int q = ph - 1, layer;
    if (q < 8) layer = 0; else if (q < 14) { layer = 1; q -= 8; } else if (q < 22) { layer = 2; q -= 14; } else { layer = 3; q -= 22; }
    const int li = layer >> 1;
    if ((layer & 1) == 0) {
        switch (q) {
            case 0: phase_even_in(cx, p, smem); convert_ffn_weights(cx, p, smem, layer); break;
            case 1: phase_even_conv(cx, p, smem, li); break;
            case 2: phase_even_states(cx, p, smem, li); break;
            case 3: phase_even_scan(cx, p); break;
            case 4: phase_even_y(cx, p, smem, li, layer); break;
            case 5: phase_even_out(cx, p, smem, layer); break;
            case 6: phase_ffn1(cx, p, smem); convert_mixer_weights(cx, p, smem, layer + 1); break;
            default: phase_ffn2(cx, p, smem, layer); break;
        }
    } else {
        switch (q) {
            case 0: phase_odd_in(cx, p, smem, layer); convert_ffn_weights(cx, p, smem, layer); break;
            case 1: phase_odd_qkv(cx, p, smem, li, layer); break;
            case 2: phase_attn(cx, p, smem, layer); break;
            case 3: phase_odd_out(cx, p, smem, layer); break;
            case 4: phase_ffn1(cx, p, smem); if (layer + 1 < 4) convert_mixer_weights(cx, p, smem, layer + 1); break;
            default: phase_ffn2(cx, p, smem, layer); break;
        }
    }
}

#define XB_TMO      128
#define XB_XCNT(j)  (256  + 64 * (j))
#define XB_XSUB(j)  (1280 + 64 * (j))
#define XB_XGEN(j)  (2304 + 64 * (j))
#define XB_TOP      3328
#define XB_TOPGEN   3392
#define XCD_BAR_WORDS 3456
#define XB_SPIN_CAP (1u << 20)
#define LAS __attribute__((address_space(3)))
DI unsigned xb_ld(unsigned* p) { return __hip_atomic_load(p, __ATOMIC_RELAXED, __HIP_MEMORY_SCOPE_AGENT); }
DI unsigned xb_add(unsigned* p, unsigned v) { return __hip_atomic_fetch_add(p, v, __ATOMIC_RELAXED, __HIP_MEMORY_SCOPE_AGENT); }
DI unsigned xb_xcc_id() { return (unsigned)__builtin_amdgcn_s_getreg((3 << 11) | 20) & 0xFu; }
#define XB_SPIN(cond, bar) do { unsigned _sp = 0; while (cond) { __builtin_amdgcn_s_sleep(1); \
    if ((++_sp & 255u) == 0u) { if (xb_ld(&(bar)[XB_TMO])) break; if (_sp > XB_SPIN_CAP) { atomicAdd(&(bar)[XB_TMO], 1u); break; } } } } while (0)
struct XcdBarrier { unsigned* bar; unsigned x; volatile LAS unsigned* st; };
DI XcdBarrier xcd_barrier_post(unsigned* bar, volatile LAS unsigned* st) {
    XcdBarrier b; b.bar = bar; b.x = xb_xcc_id(); b.st = st;
    if (threadIdx.x == 0) (void)xb_add(&bar[XB_XCNT(b.x)], 1u);
    return b;
}
DI void xcd_barrier_complete(unsigned* bar, unsigned x, unsigned& nloc, unsigned& nx) {
    const unsigned G = gridDim.x;
    unsigned sum, cnt, mine, sp = 0u;
    for (;;) {
        sum = 0u; cnt = 0u; mine = 0u;
#pragma unroll
        for (unsigned j = 0; j < 16; ++j) { const unsigned c = xb_ld(&bar[XB_XCNT(j)]); sum += c; cnt += (c > 0u) ? 1u : 0u; mine = (j == x) ? c : mine; }
        if (sum == G) break;
        __builtin_amdgcn_s_sleep(1);
        if ((++sp & 255u) == 0u) { if (xb_ld(&bar[XB_TMO])) break; if (sp > XB_SPIN_CAP) { atomicAdd(&bar[XB_TMO], 1u); break; } }
    }
    nloc = mine > 0u ? mine : 1u; nx = cnt > 0u ? cnt : 1u;
}
DI void xcd_barrier(const XcdBarrier& b) {
    asm volatile("s_waitcnt vmcnt(0)" ::: "memory");
    __syncthreads();
    if (threadIdx.x == 0) {
        unsigned* bar = b.bar;
        __builtin_amdgcn_s_waitcnt(0);
        unsigned nloc = b.st[0], nx = b.st[1];
        if (nloc == 0u) { xcd_barrier_complete(bar, b.x, nloc, nx); b.st[0] = nloc; b.st[1] = nx; }
        const unsigned old = xb_add(&bar[XB_XSUB(b.x)], 1u);
        const unsigned gen = old / nloc;
        if (old + 1u == (gen + 1u) * nloc) {
            __builtin_amdgcn_fence(__ATOMIC_RELEASE, "agent");
            asm volatile("s_waitcnt vmcnt(0)" ::: "memory");
            const unsigned og = xb_add(&bar[XB_TOP], 1u);
            const unsigned tg = og / nx;
            if (og + 1u == (tg + 1u) * nx) xb_add(&bar[XB_TOPGEN], 1u);
            else XB_SPIN(xb_ld(&bar[XB_TOPGEN]) == tg, bar);
            __builtin_amdgcn_fence(__ATOMIC_ACQUIRE, "agent");
            xb_add(&bar[XB_XGEN(b.x)], 1u);
            asm volatile("s_waitcnt vmcnt(0)" ::: "memory");
        } else {
            XB_SPIN(xb_ld(&bar[XB_XGEN(b.x)]) == gen, bar);
            __builtin_amdgcn_fence(__ATOMIC_ACQUIRE, "agent");
            asm volatile("s_waitcnt vmcnt(0)" ::: "memory");
        }
    }
    __syncthreads();
}
constexpr size_t MISC_BAR = 2 * MB;

__global__ void __launch_bounds__(256, 2) mega(P p) {
    extern __shared__ __attribute__((aligned(16))) unsigned char smem[];
    cg::grid_group grid = cg::this_grid();
    const int lo = (int)p.ph_lo, hi = (int)p.ph_hi;
    const int widx = __builtin_amdgcn_readfirstlane((int)(threadIdx.x >> 6));
    if (hi < 0) grid.sync();
    volatile LAS unsigned* xbw = (volatile LAS unsigned*)(smem + 73728);
    if (threadIdx.x == 0) { xbw[0] = 0u; xbw[1] = 0u; xbw[2] = 0u; xbw[3] = 0u; }
    __syncthreads();
    const XcdBarrier xb = xcd_barrier_post((unsigned*)(p.ws + OFF_MISC + MISC_BAR), xbw);
    for (int ph = lo; ph < hi; ++ph) {
        unsigned allm = ~0u; asm volatile("" : "+s"(allm));
        Ctx cx; cx.tid = widx * 64 + (int)__builtin_amdgcn_mbcnt_hi(allm, __builtin_amdgcn_mbcnt_lo(allm, 0u)); cx.bid = blockIdx.x; cx.nb = gridDim.x;
        asm volatile("" : "+v"(cx.tid)); asm volatile("" : "+s"(cx.bid)); asm volatile("" : "+s"(cx.nb));
#ifdef ONLY_PHASE
        run_phase(cx, p, ONLY_PHASE, smem);
#else
        run_phase(cx, p, ph, smem);
#endif
        if (ph + 1 < hi) { xcd_barrier(xb); if (PROBE_DUP == 3) xcd_barrier(xb); }
    }
}

extern "C" void kernel_launch(void* const* d_in, const int* in_sizes, int n_in, void* d_out, int out_size, void* d_ws, size_t ws_size, hipStream_t stream) {
    static int grid_blocks = 0;
    if (grid_blocks == 0) {
        int dev = 0, cus = 0, per_cu = 0;
        hipGetDevice(&dev);
        hipDeviceGetAttribute(&cus, hipDeviceAttributeMultiprocessorCount, dev);
        hipFuncSetAttribute((const void*)mega, hipFuncAttributeMaxDynamicSharedMemorySize, SMEM_BYTES);
        hipOccupancyMaxActiveBlocksPerMultiprocessor(&per_cu, (const void*)mega, 256, SMEM_BYTES);
        if (per_cu < 1) per_cu = 1;
        if (per_cu > 2) per_cu = 2;
        grid_blocks = (cus * per_cu) & ~7;
        if (ws_size < WS_NEED || n_in != 25) { fprintf(stderr, "kernel_launch: unexpected ws_size %zu / n_in %d\n", ws_size, n_in); }
        fprintf(stderr, "kernel_launch: grid %d (cus %d x %d)\n", grid_blocks, cus, per_cu);
    }
    (void)hipMemsetAsync((unsigned char*)d_ws + OFF_MISC + MISC_BAR, 0, 32768, stream);
    P p{};
    const float** pp = (const float**)&p;
    for (int i = 0; i < 25; ++i) pp[i] = (const float*)d_in[i];
    p.out = (float*)d_out; p.ws = (unsigned char*)d_ws;
#if N_LAUNCH_MODE == 1
    p.ph_lo = 0; p.ph_hi = N_PHASES;
    void* args[] = {&p};
    hipError_t e = hipLaunchCooperativeKernel((const void*)mega, dim3(grid_blocks), dim3(256), args, SMEM_BYTES, stream);
    if (e != hipSuccess) fprintf(stderr, "cooperative launch failed: %s (grid %d)\n", hipGetErrorString(e), grid_blocks);
#else
    for (int ph = 0; ph < N_PHASES; ++ph) {
        p.ph_lo = ph; p.ph_hi = ph + 1;
        hipLaunchKernelGGL(mega, dim3(grid_blocks), dim3(256), SMEM_BYTES, stream, p);
    }
#endif
}
```

```cpp
#include <hip/hip_runtime.h>
#include <hip/hip_cooperative_groups.h>
#include <cstdio>
#include <cstdint>
#include <type_traits>
namespace cg = cooperative_groups;

#define DI __device__ __forceinline__
typedef unsigned short bf16_t;
typedef short bf16x8 __attribute__((ext_vector_type(8)));
typedef short s16x4 __attribute__((ext_vector_type(4)));
typedef float f32x16 __attribute__((ext_vector_type(16)));
typedef float f32x4 __attribute__((ext_vector_type(4)));
typedef float f32x2 __attribute__((ext_vector_type(2)));
typedef __bf16 bf16x2v __attribute__((ext_vector_type(2)));
typedef unsigned u32x4 __attribute__((ext_vector_type(4)));
typedef unsigned u32x2 __attribute__((ext_vector_type(2)));

#ifndef PROBE_DUP
#define PROBE_DUP 0
#endif
#ifndef N_LAUNCH_MODE
#define N_LAUNCH_MODE 1
#endif

constexpr int T_ = 16384, S_ = 8192;
constexpr float ALPHA = 1.681792830507429f;
constexpr float LOG2E = 1.4426950408889634f;
constexpr float QS_FOX = 0.18033688011112042f;
constexpr float QS_MLA = 0.14724444602590306f;
constexpr size_t MB = 1u << 20;

constexpr size_t OFF_XB = 0;
constexpr size_t OFF_WM = 32 * MB;
constexpr size_t OFF_WF = 42 * MB;
constexpr size_t OFF_MISC = 60 * MB;
constexpr size_t OFF_R = 64 * MB;
constexpr size_t OFF_XS = 236 * MB;
constexpr size_t WS_NEED = 240 * MB;
constexpr size_t MISC_ROPE = 0;
constexpr size_t MISC_SSQ = 1 * MB;
constexpr size_t MISC_CNT = 1 * MB + 512 * 1024;
constexpr size_t MISC_NRM = 1 * MB + 768 * 1024;
constexpr size_t RE_U = 0, RE_Z = 16 * MB, RE_XBC = 48 * MB  , RE_DT = 96 * MB, RE_DTV = 97 * MB, RE_ACS = 98 * MB,
                 RE_BN = 99 * MB, RE_CN = 107 * MB, RE_BT = 115 * MB, RE_XST = 123 * MB, RE_DIFF = 155 * MB;
constexpr size_t RO_QF = 0, RO_KF = 16 * MB, RO_VF = 32 * MB, RO_CQ = 48 * MB, RO_CKV = 64 * MB, RO_KR = 72 * MB, RO_FL = 73 * MB,
                 RO_QM = 74 * MB, RO_KN = 98 * MB, RO_VM = 114 * MB, RO_FC = 130 * MB, RO_OCAT = 131 * MB;
constexpr size_t WE_IN = 0, WE_POOL = 3200 * 1024, WE_OUT = WE_POOL + 4 * 128 * 128;
constexpr size_t WO_IN = 0, WO_UQ = 2432 * 1024, WO_UKV = WO_UQ + 768 * 512, WO_OUT = WO_UKV + 1024 * 256;
constexpr size_t WF_GU = 0, WF_DN = 5632 * 1024;

constexpr int SMEM_BYTES = 73728 + 64;

struct P {
    const float *x, *even_w_in, *pool_w, *pool_scale, *conv_w, *conv_b, *dt_bias, *a_log, *d_skip, *ssm_norm_w, *even_w_out,
        *odd_w_in, *fgate_b, *q_norm_w, *w_uq, *kv_norm_w, *w_ukv, *odd_w_out, *ffn_w_gate, *ffn_w_up, *ffn_w_down,
        *ln_mix_g, *ln_mix_b, *ln_ffn_g, *ln_ffn_b;
    float* out;
    unsigned char* ws;
    long long ph_lo, ph_hi;
};

struct Ctx { int tid, bid, nb; };

__constant__ double ROPE_FREQ[16] = {1.0, 0.5623413251903491, 0.31622776601683794, 0.1778279410038923, 0.1, 0.05623413251903491,
    0.03162277660168379, 0.01778279410038923, 0.01, 0.005623413251903491, 0.0031622776601683794, 0.0017782794100389228, 0.001,
    0.0005623413251903491, 0.00031622776601683794, 0.00017782794100389227};

DI unsigned pk2(float a, float b) { f32x2 v = {a, b}; bf16x2v r = __builtin_convertvector(v, bf16x2v); return __builtin_bit_cast(unsigned, r); }
DI bf16_t f2bf(float a) { return (bf16_t)(pk2(a, 0.f) & 0xffffu); }
DI float bf2f(bf16_t v) { return __uint_as_float((unsigned)v << 16); }
DI float bflo(unsigned u) { return __uint_as_float(u << 16); }
DI float bfhi(unsigned u) { return __uint_as_float(u & 0xffff0000u); }
DI int crow(int i, int h) { return (i & 3) + 8 * (i >> 2) + 4 * h; }
DI f32x16 mfma32(bf16x8 a, bf16x8 b, f32x16 c) { return __builtin_amdgcn_mfma_f32_32x32x16_bf16(a, b, c, 0, 0, 0); }
DI f32x16 zero16() { f32x16 z; for (int i = 0; i < 16; ++i) z[i] = 0.f; return z; }
template <int s> DI bf16x8 pack8(const f32x16& x) {
    u32x4 p;
    p.x = pk2(x[8 * s + 0], x[8 * s + 1]); p.y = pk2(x[8 * s + 2], x[8 * s + 3]);
    p.z = pk2(x[8 * s + 4], x[8 * s + 5]); p.w = pk2(x[8 * s + 6], x[8 * s + 7]);
    return __builtin_bit_cast(bf16x8, p);
}
DI float silu_f(float v) { return v * __builtin_amdgcn_rcpf(1.f + __expf(-v)); }

template <int NT, bool HOOK, bool PIPE = true, class Epi, class Hook>
DI void gemm_tile(const Ctx& cx, unsigned char* smem, const bf16_t* __restrict__ A, int lda, const bf16_t* __restrict__ Bt, int ldb, int K, int m0, int n0,
                  const Epi& epi, const Hook& hook, int hook_kt) {
    constexpr int BN = 64 * NT, NB = BN / 32;
    constexpr bool DBUF = (NT == 2);
    const int tid = cx.tid, lane = tid & 63, w = __builtin_amdgcn_readfirstlane(tid >> 6), wm = w >> 1, wn = w & 1, r = lane & 31, h = lane >> 5;
    bf16_t* As = (bf16_t*)smem;
    bf16_t* Bs = As + (DBUF ? 2 : 1) * 128 * 72;
    f32x16 acc[2][NT];
#pragma unroll
    for (int a = 0; a < 2; ++a)
#pragma unroll
        for (int b = 0; b < NT; ++b) acc[a][b] = zero16();
    const int nk = K >> 6;
    const int prow = tid >> 3, pch = tid & 7;
    const bf16_t* ga = A + (size_t)(m0 + prow) * lda + pch * 8;
    const bf16_t* gb = Bt + (size_t)(n0 + prow) * ldb + pch * 8;
    u32x4 ra[4], rb[NB];
#pragma unroll
    for (int i = 0; i < 4; ++i) ra[i] = *(const u32x4*)(ga + (size_t)(32 * i) * lda);
#pragma unroll
    for (int i = 0; i < NB; ++i) rb[i] = *(const u32x4*)(gb + (size_t)(32 * i) * ldb);
#pragma unroll
    for (int i = 0; i < 4; ++i) *(u32x4*)(As + (prow + 32 * i) * 72 + pch * 8) = ra[i];
#pragma unroll
    for (int i = 0; i < NB; ++i) *(u32x4*)(Bs + (prow + 32 * i) * 72 + pch * 8) = rb[i];
    __syncthreads();
    for (int kt = 0; kt < nk; ++kt) {
        const int cur = DBUF ? (kt & 1) : 0;
        if (HOOK) { if (kt == hook_kt + 1) hook(acc, m0 + 64 * wm, lane); }
        if (kt + 1 < nk) {
#pragma unroll
            for (int i = 0; i < 4; ++i) ra[i] = *(const u32x4*)(ga + (size_t)(32 * i) * lda + (kt + 1) * 64);
#pragma unroll
            for (int i = 0; i < NB; ++i) rb[i] = *(const u32x4*)(gb + (size_t)(32 * i) * ldb + (kt + 1) * 64);
        }
        const bf16_t* as = As + cur * 128 * 72 + (64 * wm + r) * 72 + 8 * h;
        const bf16_t* bs = Bs + cur * BN * 72 + (32 * NT * wn + r) * 72 + 8 * h;
        __builtin_amdgcn_s_setprio(1);
        {
            bf16x8 a0 = *(const bf16x8*)(as), a1 = *(const bf16x8*)(as + 32 * 72), bc = *(const bf16x8*)(bs);
            bf16x8 a0n = a0, a1n = a1;
#pragma unroll
            for (int step = 0; step < 4 * NT; ++step) {
                const int ks = step / NT, nt = step % NT;
                bf16x8 bn = bc;
                if (step + 1 < 4 * NT) bn = *(const bf16x8*)(bs + ((step + 1) % NT) * 32 * 72 + ((step + 1) / NT) * 16);
                if (nt == NT - 2 && ks < 3) { a0n = *(const bf16x8*)(as + (ks + 1) * 16); a1n = *(const bf16x8*)(as + 32 * 72 + (ks + 1) * 16); }
                if (PIPE) __builtin_amdgcn_sched_barrier(0);
                acc[0][nt] = mfma32(a0, bc, acc[0][nt]); acc[1][nt] = mfma32(a1, bc, acc[1][nt]);
                bc = bn;
                if (nt == NT - 1) { a0 = a0n; a1 = a1n; }
            }
        }
        __builtin_amdgcn_s_setprio(0);
        if (!DBUF) __syncthreads();
        if (kt + 1 < nk) {
            const int nx = DBUF ? (cur ^ 1) : 0;
#pragma unroll
            for (int i = 0; i < 4; ++i) *(u32x4*)(As + nx * 128 * 72 + (prow + 32 * i) * 72 + pch * 8) = ra[i];
#pragma unroll
            for (int i = 0; i < NB; ++i) *(u32x4*)(Bs + nx * BN * 72 + (prow + 32 * i) * 72 + pch * 8) = rb[i];
        }
        __syncthreads();
    }
    epi(acc, m0 + 64 * wm, n0 + 32 * NT * wn, lane);
}
struct NoHook { template <class ACC> DI void operator()(ACC&, int, int) const {} };

template <bool HOOK, bool REM = true, bool PIPE = true, bool HALF = false, class Epi, class Hook>
DI void gemm_phase(const Ctx& cx, unsigned char* smem, const bf16_t* A, int lda, const bf16_t* Bt, int ldb, int K, int M, int N, const Epi& epi, const Hook& hook, int hook_kt) {
    const int tn = N >> 8, tm = M >> 7;
    const int x = cx.bid & 7, l = cx.bid >> 3, c = cx.nb >> 3, pr = tm >> 3, len = pr * tn;
    const int rounds = len / c, rem = len - rounds * c, nh = (HALF && rem > 0 && 2 * rem <= c) ? 2 * rem : 0, lenfull = nh ? rounds * c : len;
    for (int sidx = l; sidx < lenfull; sidx += c) gemm_tile<4, HOOK, PIPE>(cx, smem, A, lda, Bt, ldb, K, (x * pr + sidx / tn) * 128, (sidx % tn) * 256, epi, hook, hook_kt);
    if (REM || HALF) {
        const int nrem = (REM && (N & 128)) ? pr : 0;
        for (int u = c - 1 - l; u < nh + nrem; u += c) {
            int m0, n0;
            if (u < nh) { const int sidx = lenfull + (u >> 1); m0 = (x * pr + sidx / tn) * 128; n0 = (sidx % tn) * 256 + (u & 1) * 128; }
            else { m0 = (x * pr + (u - nh)) * 128; n0 = tn * 256; }
            gemm_tile<2, HOOK>(cx, smem, A, lda, Bt, ldb, K, m0, n0, epi, hook, hook_kt);
        }
    }
}
template <int NT, class F> DI void epi_each(f32x16 (&acc)[2][NT], int mb, int nb, int lane, const F& f) {
    const int h = lane >> 5, c = lane & 31;
#pragma unroll
    for (int mt = 0; mt < 2; ++mt)
#pragma unroll
        for (int i4 = 0; i4 < 4; ++i4) {
            int rb = mb + 32 * mt + 8 * i4 + 4 * h;
            asm volatile("" : "+v"(rb));
#pragma unroll
            for (int nt = 0; nt < NT; ++nt)
#pragma unroll
                for (int j = 0; j < 4; ++j) f(rb + j, nb + 32 * nt + c, acc[mt][nt][4 * i4 + j]);
        }
}

template <class F> DI void conv_task(const Ctx& cx, unsigned char* smem, bf16_t* dst, int N, int K, const F& f) {
    float* tile = (float*)smem;
    const int tid = cx.tid, tx = tid & 63, ty = tid >> 6;
    const int tk = K >> 6, nt = (N >> 6) * tk;
    float v[16];
    int t = cx.bid;
    if (t < nt) {
        const int n0 = (t / tk) * 64, k0 = (t % tk) * 64;
#pragma unroll
        for (int i = 0; i < 16; ++i) v[i] = f(k0 + ty + 4 * i, n0 + tx);
    }
    while (t < nt) {
        const int n0 = (t / tk) * 64, k0 = (t % tk) * 64;
#pragma unroll
        for (int i = 0; i < 16; ++i) tile[(ty + 4 * i) * 65 + tx] = v[i];
        __syncthreads();
        const int tnx = t + cx.nb;
        if (tnx < nt) {
            const int n1 = (tnx / tk) * 64, k1 = (tnx % tk) * 64;
#pragma unroll
            for (int i = 0; i < 16; ++i) v[i] = f(k1 + ty + 4 * i, n1 + tx);
        }
        const int nl = tid >> 2, ks = (tid & 3) * 16;
        u32x4 o0, o1;
        o0.x = pk2(tile[(ks + 0) * 65 + nl], tile[(ks + 1) * 65 + nl]); o0.y = pk2(tile[(ks + 2) * 65 + nl], tile[(ks + 3) * 65 + nl]);
        o0.z = pk2(tile[(ks + 4) * 65 + nl], tile[(ks + 5) * 65 + nl]); o0.w = pk2(tile[(ks + 6) * 65 + nl], tile[(ks + 7) * 65 + nl]);
        o1.x = pk2(tile[(ks + 8) * 65 + nl], tile[(ks + 9) * 65 + nl]); o1.y = pk2(tile[(ks + 10) * 65 + nl], tile[(ks + 11) * 65 + nl]);
        o1.z = pk2(tile[(ks + 12) * 65 + nl], tile[(ks + 13) * 65 + nl]); o1.w = pk2(tile[(ks + 14) * 65 + nl], tile[(ks + 15) * 65 + nl]);
        bf16_t* d = dst + (size_t)(n0 + nl) * K + k0 + ks;
        *(u32x4*)d = o0; *(u32x4*)(d + 8) = o1;
        __syncthreads();
        t = tnx;
    }
}
DI void convert_mixer_weights(const Ctx& cx, const P& p, unsigned char* smem, int layer) {
    bf16_t* wm = (bf16_t*)(p.ws + OFF_WM);
    const int li = layer >> 1;
    if ((layer & 1) == 0) {
        const float* win = p.even_w_in + (size_t)li * 1024 * 3088;
        conv_task(cx, smem, wm + WE_IN, 3200, 1024, [=](int k, int n) { return n < 3088 ? win[(size_t)k * 3088 + n] : 0.f; });
        const float* pw = p.pool_w + (size_t)li * 4 * 128 * 128;
        conv_task(cx, smem, wm + WE_POOL, 512, 128, [=](int k, int n) { return pw[(size_t)(n >> 7) * 16384 + k * 128 + (n & 127)]; });
        const float* wo = p.even_w_out + (size_t)li * 1536 * 1024;
        conv_task(cx, smem, wm + WE_OUT, 1024, 1536, [=](int k, int n) { const int kr = k < 1024 ? k + 512 : k - 1024; return wo[(size_t)kr * 1024 + n]; });
    } else {
        const float* win = p.odd_w_in + (size_t)li * 1024 * 2344;
        conv_task(cx, smem, wm + WO_IN, 2432, 1024, [=](int k, int n) {
            int c;
            if (n < 1536) c = n; else if (n < 2048) c = 1544 + (n - 1536); else if (n < 2304) c = 2056 + (n - 2048);
            else if (n < 2336) c = 2312 + (n - 2304); else if (n < 2344) c = 1536 + (n - 2336); else c = -1;
            return c >= 0 ? win[(size_t)k * 2344 + c] : 0.f; });
        const float* uq = p.w_uq + (size_t)li * 512 * 768; const float* qn = p.q_norm_w + li * 512;
        conv_task(cx, smem, wm + WO_UQ, 768, 512, [=](int k, int n) { return uq[(size_t)k * 768 + n] * qn[k]; });
        const float* ukv = p.w_ukv + (size_t)li * 256 * 1024; const float* kn = p.kv_norm_w + li * 256;
        conv_task(cx, smem, wm + WO_UKV, 1024, 256, [=](int k, int n) { return ukv[(size_t)k * 1024 + n] * kn[k]; });
        const float* wo = p.odd_w_out + (size_t)li * 1024 * 1024;
        conv_task(cx, smem, wm + WO_OUT, 1024, 1024, [=](int k, int n) { return wo[(size_t)k * 1024 + n]; });
    }
}
DI void convert_ffn_weights(const Ctx& cx, const P& p, unsigned char* smem, int layer) {
    bf16_t* wf = (bf16_t*)(p.ws + OFF_WF);
    const float* g = p.ffn_w_gate + (size_t)layer * 1024 * 2816; const float* u = p.ffn_w_up + (size_t)layer * 1024 * 2816;
    conv_task(cx, smem, wf + WF_GU, 5632, 1024, [=](int k, int n) { const int q = n >> 6, r = n & 63; return r < 32 ? g[(size_t)k * 2816 + 32 * q + r] : u[(size_t)k * 2816 + 32 * q + r - 32]; });
    const float* d = p.ffn_w_down + (size_t)layer * 2816 * 1024;
    conv_task(cx, smem, wf + WF_DN, 1024, 2816, [=](int k, int n) { return d[(size_t)k * 1024 + n]; });
}

DI void phase_prep(const Ctx& cx, const P& p, unsigned char* smem) {
    const size_t gt = (size_t)cx.bid * 256 + cx.tid, gs = (size_t)cx.nb * 256;
    bf16_t* xb = (bf16_t*)(p.ws + OFF_XB);
    for (size_t i = gt; i < (size_t)T_ * 1024 / 4; i += gs) {
        const f32x4 v = *(const f32x4*)(p.x + i * 4);
        u32x2 o; o.x = pk2(v[0], v[1]); o.y = pk2(v[2], v[3]);
        *(u32x2*)(xb + i * 4) = o;
    }
    f32x2* rope = (f32x2*)(p.ws + OFF_MISC + MISC_ROPE);
    for (size_t i = gt; i < (size_t)S_ * 16; i += gs) {
        const int pos = (int)(i >> 4), fi = (int)(i & 15);
        const double ang = (double)pos * ROPE_FREQ[fi];
        const double k = __builtin_rint(ang * 0.15915494309189535);
        const float rr = (float)(ang - k * 6.283185307179586);
        rope[i] = (f32x2){cosf(rr), sinf(rr)};
    }
    float* ssq = (float*)(p.ws + OFF_MISC + MISC_SSQ);
    for (size_t i = gt; i < (size_t)4 * 2 * T_; i += gs) ssq[i] = 0.f;
    int* cnt = (int*)(p.ws + OFF_MISC + MISC_CNT);
    if (gt < 16) cnt[gt] = 0;
    if (gt < 128) ((unsigned*)(p.ws + OFF_MISC + MISC_NRM))[gt] = 0u;
    convert_mixer_weights(cx, p, smem, 0);
}

DI void phase_ln(const Ctx& cx, const P& p, const float* g, const float* b, bool write_xb) {
    const int lane = cx.tid & 63, wv = __builtin_amdgcn_readfirstlane(cx.tid >> 6);
    bf16_t* xb = (bf16_t*)(p.ws + OFF_XB);
    for (int row = cx.bid * 4 + wv; row < T_; row += cx.nb * 4) {
        float* xr = p.out + (size_t)row * 1024;
        f32x4 v[4]; float s = 0.f;
#pragma unroll
        for (int i = 0; i < 4; ++i) { v[i] = *(const f32x4*)(xr + i * 256 + lane * 4); s += (v[i][0] + v[i][1]) + (v[i][2] + v[i][3]); }
#pragma unroll
        for (int o = 32; o >= 1; o >>= 1) s += __shfl_xor(s, o);
        const float mu = s * (1.f / 1024.f); float q = 0.f;
#pragma unroll
        for (int i = 0; i < 4; ++i) { const f32x4 d = v[i] - mu; q += (d[0] * d[0] + d[1] * d[1]) + (d[2] * d[2] + d[3] * d[3]); }
#pragma unroll
        for (int o = 32; o >= 1; o >>= 1) q += __shfl_xor(q, o);
        const float rstd = 1.0f / sqrtf(q * (1.f / 1024.f) + 1e-5f);
#pragma unroll
        for (int i = 0; i < 4; ++i) {
            const int c = i * 256 + lane * 4;
            const f32x4 gg = *(const f32x4*)(g + c), bb = *(const f32x4*)(b + c);
            const f32x4 o = (v[i] - mu) * rstd * gg + bb;
            *(f32x4*)(xr + c) = o;
            if (write_xb) { u32x2 w; w.x = pk2(o[0], o[1]); w.y = pk2(o[2], o[3]); *(u32x2*)(xb + (size_t)row * 1024 + c) = w; }
        }
    }
}

constexpr size_t MISC_LNCNT = 2 * MB + 16384;
struct EpiResidLN {
    float* X; const float* Xin; bf16_t* Xb; const float* g; const float* b; unsigned long long* xs; unsigned* cnt; unsigned inst; unsigned char* smem; int tid;
    template <int NT> DI void operator()(f32x16 (&acc)[2][NT], int mb, int nb, int lane) const {
        const int h = lane >> 5, c = lane & 31, wn = __builtin_amdgcn_readfirstlane((tid >> 6) & 1);
        const int panel = mb >> 7, ct = nb / (64 * NT), ntn = 1024 / (64 * NT);
        f32x2* Pl = (f32x2*)smem;
        f32x2* Sl = Pl + 256;
#pragma unroll
        for (int mt = 0; mt < 2; ++mt)
#pragma unroll
            for (int i4 = 0; i4 < 4; ++i4) {
                int rb = mb + 32 * mt + 8 * i4 + 4 * h;
                asm volatile("" : "+v"(rb));
#pragma unroll
                for (int j = 0; j < 4; ++j) {
                    unsigned xo = (unsigned)((rb + j) * 1024 + nb + c);
                    asm volatile("" : "+v"(xo));
                    float sm = 0.f, sq = 0.f;
#pragma unroll
                    for (int nt = 0; nt < NT; ++nt) { const float v = ALPHA * Xin[xo + 32 * nt] + acc[mt][nt][4 * i4 + j]; acc[mt][nt][4 * i4 + j] = v; sm += v; sq += v * v; }
                    sm += __shfl_xor(sm, 1); sq += __shfl_xor(sq, 1); sm += __shfl_xor(sm, 2); sq += __shfl_xor(sq, 2); sm += __shfl_xor(sm, 4); sq += __shfl_xor(sq, 4);
                    sm += __shfl_xor(sm, 8); sq += __shfl_xor(sq, 8); sm += __shfl_xor(sm, 16); sq += __shfl_xor(sq, 16);
                    if (c == 0) Pl[((rb + j) & 127) * 2 + wn] = (f32x2){sm, sq};
                }
            }
        __syncthreads();
        if (tid < 128) {
            const f32x2 p0 = Pl[tid * 2], p1 = Pl[tid * 2 + 1];
            const unsigned long long val = ((unsigned long long)__float_as_uint(p0.y + p1.y) << 32) | __float_as_uint(p0.x + p1.x);
            __hip_atomic_store(xs + (((size_t)inst * T_ + panel * 128 + tid) * 4 + ct), val, __ATOMIC_RELAXED, __HIP_MEMORY_SCOPE_AGENT);
        }
        asm volatile("s_waitcnt vmcnt(0)" ::: "memory");
        __syncthreads();
        if (tid == 0) {
            __hip_atomic_fetch_add(cnt + panel, 1u, __ATOMIC_RELAXED, __HIP_MEMORY_SCOPE_AGENT);
            const unsigned want = (unsigned)ntn * (inst + 1u);
            unsigned sp = 0;
            while (__hip_atomic_load(cnt + panel, __ATOMIC_RELAXED, __HIP_MEMORY_SCOPE_AGENT) < want) { __builtin_amdgcn_s_sleep(1); if (++sp > (1u << 22)) break; }
            __builtin_amdgcn_fence(__ATOMIC_ACQUIRE, "agent");
        }
        __syncthreads();
        if (tid < 128) {
            const unsigned long long* sl = xs + ((size_t)inst * T_ + panel * 128 + tid) * 4;
            float sm = 0.f, sq = 0.f;
#pragma unroll
            for (int t = 0; t < 4; ++t) if (t < ntn) { const unsigned long long wv = __hip_atomic_load(sl + t, __ATOMIC_RELAXED, __HIP_MEMORY_SCOPE_AGENT); sm += __uint_as_float((unsigned)wv); sq += __uint_as_float((unsigned)(wv >> 32)); }
            const float mu = sm * (1.f / 1024.f), var = fmaxf(sq * (1.f / 1024.f) - mu * mu, 0.f);
            Sl[tid] = (f32x2){mu, 1.0f / sqrtf(var + 1e-5f)};
        }
        __syncthreads();
        float gg[NT], bb[NT];
#pragma unroll
        for (int nt = 0; nt < NT; ++nt) { gg[nt] = g[nb + 32 * nt + c]; bb[nt] = b[nb + 32 * nt + c]; }
#pragma unroll
        for (int mt = 0; mt < 2; ++mt)
#pragma unroll
            for (int i4 = 0; i4 < 4; ++i4) {
                int rb = mb + 32 * mt + 8 * i4 + 4 * h;
                asm volatile("" : "+v"(rb));
#pragma unroll
                for (int j = 0; j < 4; ++j) {
                    const f32x2 ms = Sl[(rb + j) & 127];
                    unsigned off = (unsigned)((rb + j) * 1024 + nb + c);
                    asm volatile("" : "+v"(off));
#pragma unroll
                    for (int nt = 0; nt < NT; ++nt) {
                        const float o = (acc[mt][nt][4 * i4 + j] - ms.x) * ms.y * gg[nt] + bb[nt];
                        X[off + 32 * nt] = o;
                        if (Xb) Xb[off + 32 * nt] = f2bf(o);
                    }
                }
            }
        __syncthreads();
    }
};
DI EpiResidLN make_ln_epi(const Ctx& cx, const P& p, unsigned char* smem, int layer, int which  ) {
    EpiResidLN e;
    e.X = p.out; e.Xin = (layer == 0 && which == 0) ? p.x : p.out; e.Xb = (layer == 3 && which == 1) ? (bf16_t*)nullptr : (bf16_t*)(p.ws + OFF_XB);
    e.g = (which ? p.ln_ffn_g : p.ln_mix_g) + layer * 1024; e.b = (which ? p.ln_ffn_b : p.ln_mix_b) + layer * 1024;
    e.xs = (unsigned long long*)(p.ws + OFF_XS); e.cnt = (unsigned*)(p.ws + OFF_MISC + MISC_LNCNT); e.inst = (unsigned)(layer * 2 + which);
    e.smem = smem; e.tid = cx.tid;
    return e;
}

DI void phase_ffn1(const Ctx& cx, const P& p, unsigned char* smem) {
    bf16_t* H = (bf16_t*)(p.ws + OFF_R);
    const int wv = __builtin_amdgcn_readfirstlane(cx.tid >> 6);
    auto epi = [=](auto& acc, int mb, int nb, int lane) {
        constexpr int NT = sizeof(acc[0]) / sizeof(f32x16), OC = 16 * NT, RS = OC + 8, CPR = OC / 8;
        asm volatile("" : "+v"(lane));
        const int h = lane >> 5, c = lane & 31;
        bf16_t* stg = (bf16_t*)smem + wv * (64 * RS);
#pragma unroll
        for (int np = 0; np < NT / 2; ++np)
#pragma unroll
            for (int mt = 0; mt < 2; ++mt)
#pragma unroll
                for (int i = 0; i < 16; ++i) {
                    const float gv = acc[mt][2 * np][i], uv = acc[mt][2 * np + 1][i];
                    stg[(32 * mt + crow(i, h)) * RS + 32 * np + c] = f2bf(silu_f(gv) * uv);
                    if ((i & 3) == 3) __builtin_amdgcn_sched_barrier(0);
                }
        bf16_t* hb = H + (size_t)mb * 2816 + (nb >> 6) * 32;
#pragma unroll
        for (int q = 0; q < CPR; ++q) {
            const int idx = q * 64 + lane, rl = idx / CPR, ch = idx % CPR;
            const u32x4 v = *(const u32x4*)(stg + rl * RS + ch * 8);
            *(u32x4*)(hb + (size_t)rl * 2816 + ch * 8) = v;
        }
        __syncthreads();
    };
    gemm_phase<false, false, true, true>(cx, smem, (const bf16_t*)(p.ws + OFF_XB), 1024, (const bf16_t*)(p.ws + OFF_WF) + WF_GU, 1024, 1024, T_, 5632, epi, NoHook(), -1);
}
DI void phase_ffn2(const Ctx& cx, const P& p, unsigned char* smem, int layer) {
    const EpiResidLN epi = make_ln_epi(cx, p, smem, layer, 1);
    gemm_phase<false, false>(cx, smem, (const bf16_t*)(p.ws + OFF_R), 2816, (const bf16_t*)(p.ws + OFF_WF) + WF_DN, 2816, 2816, T_, 1024, epi, NoHook(), -1);
}

DI void phase_even_in(const Ctx& cx, const P& p, unsigned char* smem) {
    unsigned char* R = p.ws + OFF_R;
    bf16_t* U = (bf16_t*)(R + RE_U); bf16_t* Z = (bf16_t*)(R + RE_Z); bf16_t* XBC = (bf16_t*)(R + RE_XBC); float* DT = (float*)(R + RE_DT);
    const int wv = __builtin_amdgcn_readfirstlane(cx.tid >> 6);
    auto epi = [=](auto& acc, int mb, int nb, int lane) {
        constexpr int NT = sizeof(acc[0]) / sizeof(f32x16);
        if constexpr (NT == 4) {
            constexpr int RS = 136;
            asm volatile("" : "+v"(lane));
            const int h = lane >> 5, c = lane & 31;
            bf16_t* stg = (bf16_t*)smem + wv * (64 * RS);
#pragma unroll
            for (int mt = 0; mt < 2; ++mt)
#pragma unroll
                for (int nt = 0; nt < 4; ++nt)
#pragma unroll
                    for (int i = 0; i < 16; ++i) stg[(32 * mt + crow(i, h)) * RS + 32 * nt + c] = f2bf(acc[mt][nt][i]);
            bf16_t* db; int ld;
            if (nb < 512) { db = U + nb; ld = 512; } else if (nb < 1536) { db = Z + (nb - 512); ld = 1024; } else { db = XBC + (nb - 1536); ld = 1536; }
            db += (size_t)mb * ld;
#pragma unroll
            for (int q = 0; q < 16; ++q) {
                const int idx = q * 64 + lane, rl = idx >> 4, ch = idx & 15;
                const u32x4 v = *(const u32x4*)(stg + rl * RS + ch * 8);
                *(u32x4*)(db + (size_t)rl * ld + ch * 8) = v;
            }
            __syncthreads();
        } else {
            epi_each(acc, mb, nb, lane, [=](int row, int col, float v) {
                if (col < 512) U[(size_t)row * 512 + col] = f2bf(v);
                else if (col < 1536) Z[(size_t)row * 1024 + col - 512] = f2bf(v);
                else if (col < 3072) XBC[(size_t)row * 1536 + col - 1536] = f2bf(v);
                else if (col < 3088) DT[(size_t)row * 16 + col - 3072] = v;
            });
        }
    };
    gemm_phase<false>(cx, smem, (const bf16_t*)(p.ws + OFF_XB), 1024, (const bf16_t*)(p.ws + OFF_WM) + WE_IN, 1024, 1024, T_, 3200, epi, NoHook(), -1);
}

DI void phase_even_conv(const Ctx& cx, const P& p, unsigned char* smem, int li) {
    unsigned char* R = p.ws + OFF_R;
    const bf16_t* U = (const bf16_t*)(R + RE_U); const bf16_t* XBC = (const bf16_t*)(R + RE_XBC); const float* DT = (const float*)(R + RE_DT);
    float* DTV = (float*)(R + RE_DTV); float* ACS = (float*)(R + RE_ACS);
    bf16_t* BN = (bf16_t*)(R + RE_BN); bf16_t* CN = (bf16_t*)(R + RE_CN); bf16_t* BT = (bf16_t*)(R + RE_BT); bf16_t* XST = (bf16_t*)(R + RE_XST);
    bf16_t* DIFF = (bf16_t*)(R + RE_DIFF);
    const float* cw = p.conv_w + (size_t)li * 4 * 1536; const float* cb = p.conv_b + (size_t)li * 1536;
    const float* dtb = p.dt_bias + li * 16; const float* alog = p.a_log + li * 16;
    const int tid = cx.tid;
    float* sseg = (float*)smem;
    for (int u = cx.bid; u < 128 * 9; u += cx.nb) {
        const int bc = u / 9, sub = u % 9, b = bc >> 6, c = bc & 63, t0 = b * S_ + c * 128, pos0 = c * 128;
        if (sub < 6) {
            const int ch = sub * 256 + tid;
            const float w0 = cw[ch], w1 = cw[1536 + ch], w2 = cw[2 * 1536 + ch], w3 = cw[3 * 1536 + ch], bias = cb[ch];
            float x0 = pos0 >= 3 ? bf2f(XBC[(size_t)(t0 - 3) * 1536 + ch]) : 0.f;
            float x1 = pos0 >= 2 ? bf2f(XBC[(size_t)(t0 - 2) * 1536 + ch]) : 0.f;
            float x2 = pos0 >= 1 ? bf2f(XBC[(size_t)(t0 - 1) * 1536 + ch]) : 0.f;
            for (int l = 0; l < 128; l += 32) {
                float xin[32];
#pragma unroll
                for (int j = 0; j < 32; ++j) xin[j] = bf2f(XBC[(size_t)(t0 + l + j) * 1536 + ch]);
#pragma unroll
                for (int q8 = 0; q8 < 4; ++q8) {
                    float o[8];
#pragma unroll
                    for (int j = 0; j < 8; ++j) {
                        const float x3 = xin[8 * q8 + j];
                        const float y = w0 * x0 + w1 * x1 + w2 * x2 + w3 * x3 + bias;
                        o[j] = silu_f(y); x0 = x1; x1 = x2; x2 = x3;
                    }
                    const int lq = l + 8 * q8;
                    u32x4 pk; pk.x = pk2(o[0], o[1]); pk.y = pk2(o[2], o[3]); pk.z = pk2(o[4], o[5]); pk.w = pk2(o[6], o[7]);
                    if (sub < 4) { *(u32x4*)(XST + ((size_t)b * 1024 + ch) * S_ + pos0 + lq) = pk; }
                    else if (sub == 4) {
                        const int cc = ch - 1024;
                        *(u32x4*)(BT + ((size_t)b * 256 + cc) * S_ + pos0 + lq) = pk;
#pragma unroll
                        for (int j = 0; j < 8; ++j) BN[(size_t)(t0 + lq + j) * 256 + cc] = f2bf(o[j]);
                    } else {
                        const int cc = ch - 1280;
#pragma unroll
                        for (int j = 0; j < 8; ++j) CN[(size_t)(t0 + lq + j) * 256 + cc] = f2bf(o[j]);
                    }
                }
            }
        } else if (sub == 6) {
            const int hd = tid & 15, seg = tid >> 4;
            const float a = -__expf(alog[hd]), db = dtb[hd];
            float sp[8], cum = 0.f;
#pragma unroll
            for (int j = 0; j < 8; ++j) {
                const float v = DT[(size_t)(t0 + seg * 8 + j) * 16 + hd] + db;
                sp[j] = v > 20.f ? v : log1pf(expf(v));
                cum += sp[j] * a;
            }
            sseg[seg * 16 + hd] = cum;
            __syncthreads();
            float base = 0.f;
            for (int s2 = 0; s2 < seg; ++s2) base += sseg[s2 * 16 + hd];
            cum = base;
#pragma unroll
            for (int j = 0; j < 8; ++j) {
                cum += sp[j] * a;
                DTV[(size_t)(t0 + seg * 8 + j) * 16 + hd] = sp[j];
                ACS[(size_t)(t0 + seg * 8 + j) * 16 + hd] = cum;
            }
            __syncthreads();
        } else {
            const int ch = (sub - 7) * 256 + tid, g = ch >> 7, w = 2 << g;
            float s = 0.f;
            for (int j = 1; j < w; ++j) if (pos0 - j >= 0) s += bf2f(U[(size_t)(t0 - j) * 512 + ch]);
            for (int l0 = 0; l0 < 128; l0 += 32) {
                float cu[32], old[32];
#pragma unroll
                for (int j = 0; j < 32; ++j) {
                    cu[j] = bf2f(U[(size_t)(t0 + l0 + j) * 512 + ch]);
                    const int po = pos0 + l0 + j - w + 1;
                    old[j] = po >= 0 ? bf2f(U[(size_t)(t0 + l0 + j - w + 1) * 512 + ch]) : 0.f;
                }
#pragma unroll
                for (int j = 0; j < 32; ++j) {
                    const int pos = pos0 + l0 + j;
                    s += cu[j];
                    const int cnt = pos + 1 < w ? pos + 1 : w;
                    DIFF[(size_t)(t0 + l0 + j) * 512 + ch] = f2bf(s / (float)cnt - cu[j]);
                    s -= old[j];
                }
            }
        }
    }
}

DI void phase_even_states(const Ctx& cx, const P& p, unsigned char* smem, int li) {
    unsigned char* R = p.ws + OFF_R;
    const float* DTV = (const float*)(R + RE_DTV); const float* ACS = (const float*)(R + RE_ACS);
    const bf16_t* BT = (const bf16_t*)(R + RE_BT); const bf16_t* XST = (const bf16_t*)(R + RE_XST);
    bf16_t* ST = (bf16_t*)(p.ws + OFF_XB);
    const int tid = cx.tid, lane = tid & 63, w = __builtin_amdgcn_readfirstlane(tid >> 6), r = lane & 31, h = lane >> 5;
    float* wsc = (float*)smem;
    for (int u = cx.bid; u < 2048; u += cx.nb) {
        const int H = u & 15, c = (u >> 4) & 63, b = u >> 10, g = H >> 3, t0 = b * S_ + c * 128, pos0 = c * 128;
        if (tid < 128) wsc[tid] = DTV[(size_t)(t0 + tid) * 16 + H] * __expf(ACS[(size_t)(t0 + 127) * 16 + H] - ACS[(size_t)(t0 + tid) * 16 + H]);
        __syncthreads();
        f32x16 acc[2] = {zero16(), zero16()};
        const int n0 = 32 * w;
#pragma unroll
        for (int st = 0; st < 8; ++st) {
            const int kb = 16 * st + 8 * h;
            const bf16x8 bf = *(const bf16x8*)(BT + ((size_t)b * 256 + g * 128 + n0 + r) * S_ + pos0 + kb);
            const f32x4 wa = *(const f32x4*)(wsc + kb), wb = *(const f32x4*)(wsc + kb + 4);
#pragma unroll
            for (int pt = 0; pt < 2; ++pt) {
                const u32x4 raw = *(const u32x4*)(XST + ((size_t)b * 1024 + H * 64 + 32 * pt + r) * S_ + pos0 + kb);
                u32x4 sc;
                sc.x = pk2(bflo(raw.x) * wa[0], bfhi(raw.x) * wa[1]); sc.y = pk2(bflo(raw.y) * wa[2], bfhi(raw.y) * wa[3]);
                sc.z = pk2(bflo(raw.z) * wb[0], bfhi(raw.z) * wb[1]); sc.w = pk2(bflo(raw.w) * wb[2], bfhi(raw.w) * wb[3]);
                acc[pt] = mfma32(__builtin_bit_cast(bf16x8, sc), bf, acc[pt]);
            }
        }
#pragma unroll
        for (int pt = 0; pt < 2; ++pt)
#pragma unroll
            for (int i = 0; i < 16; ++i)
                ST[((((size_t)b * 64 + c) * 16 + H) * 64 + 32 * pt + crow(i, h)) * 128 + n0 + r] = f2bf(acc[pt][i]);
        __syncthreads();
    }
    {
        const bf16_t* DIFF = (const bf16_t*)(R + RE_DIFF); bf16_t* YC = (bf16_t*)(R + RE_XBC);
        const bf16_t* PW = (const bf16_t*)(p.ws + OFF_WM) + WE_POOL;
        const float* psc = p.pool_scale + li * 512;
        for (int t = cx.bid; t < 512; t += cx.nb) {
            const int g = t & 3, mt = t >> 2;
            auto epi = [=](auto& acc, int mb, int nb, int lane2) {
                epi_each(acc, mb, nb, lane2, [=](int row, int col, float v) { YC[(size_t)row * 1536 + 1024 + g * 128 + col] = f2bf(v * psc[g * 128 + col]); });
            };
            gemm_tile<2, false>(cx, smem, DIFF + g * 128, 512, PW + (size_t)g * 128 * 128, 128, 128, mt * 128, 0, epi, NoHook(), -1);
        }
    }
}

DI void phase_even_scan(const Ctx& cx, const P& p) {
    unsigned char* R = p.ws + OFF_R;
    const float* ACS = (const float*)(R + RE_ACS);
    bf16_t* ST = (bf16_t*)(p.ws + OFF_XB);
    for (int e = cx.bid * 256 + cx.tid; e < 262144; e += cx.nb * 256) {
        const int n = e & 127, pp = (e >> 7) & 63, H = (e >> 13) & 15, b = e >> 17;
        float hst = 0.f;
        bf16_t* sp = ST + (((size_t)b * 64 * 16 + H) * 64 + pp) * 128 + n;
        const float* ap = ACS + (size_t)(b * S_ + 127) * 16 + H;
#pragma unroll 1
        for (int c0 = 0; c0 < 64; c0 += 16) {
            float st[16], dec[16];
#pragma unroll
            for (int j = 0; j < 16; ++j) { st[j] = bf2f(sp[(size_t)(c0 + j) * (16 * 64 * 128)]); dec[j] = ap[(size_t)(c0 + j) * (128 * 16)]; }
#pragma unroll
            for (int j = 0; j < 16; ++j) {
                sp[(size_t)(c0 + j) * (16 * 64 * 128)] = f2bf(hst);
                hst = hst * __expf(dec[j]) + st[j];
            }
        }
    }
}

DI void phase_even_y(const Ctx& cx, const P& p, unsigned char* smem, int li, int layer) {
    unsigned char* R = p.ws + OFF_R;
    const float* DTV = (const float*)(R + RE_DTV); const float* ACS = (const float*)(R + RE_ACS);
    const bf16_t* BN = (const bf16_t*)(R + RE_BN); const bf16_t* CN = (const bf16_t*)(R + RE_CN); const bf16_t* XST = (const bf16_t*)(R + RE_XST);
    const bf16_t* Z = (const bf16_t*)(R + RE_Z); bf16_t* YC = (bf16_t*)(R + RE_XBC);
    const bf16_t* PREV = (const bf16_t*)(p.ws + OFF_XB);
    float* SSQ = (float*)(p.ws + OFF_MISC + MISC_SSQ) + (size_t)layer * 2 * T_;
    const float* dsk = p.d_skip + li * 16; const float* nw = p.ssm_norm_w + li * 1024;
    const int tid = cx.tid, lane = tid & 63, w = __builtin_amdgcn_readfirstlane(tid >> 6), r = lane & 31, h = lane >> 5;
    float* sacs = (float*)smem;
    float* sdtv = sacs + 512;
    for (int u = cx.bid; u < 512; u += cx.nb) {
        const int hh = u & 1, g = (u >> 1) & 1, c = (u >> 2) & 63, b = u >> 8, t0 = b * S_ + c * 128, pos0 = c * 128, l0 = 32 * w;
        for (int idx = tid; idx < 512; idx += 256) {
            const int k = idx >> 7, l = idx & 127, H = g * 8 + hh * 4 + k;
            sacs[idx] = ACS[(size_t)(t0 + l) * 16 + H]; sdtv[idx] = DTV[(size_t)(t0 + l) * 16 + H];
        }
        __syncthreads();
        const bf16_t* crow_p = CN + (size_t)(t0 + l0 + r) * 256 + g * 128 + 8 * h;
        u32x4* xl = (u32x4*)(smem + 4096) + w * 512;
#pragma unroll 1
        for (int st = 0; st <= w; ++st) {
            f32x16 xt = zero16();
            const bf16_t* brow_p = BN + (size_t)(t0 + 32 * st + r) * 256 + g * 128 + 8 * h;
#pragma unroll
            for (int k = 0; k < 8; ++k) xt = mfma32(*(const bf16x8*)(brow_p + 16 * k), *(const bf16x8*)(crow_p + 16 * k), xt);
            xl[(st * 2 + 0) * 64 + lane] = __builtin_bit_cast(u32x4, pack8<0>(xt));
            xl[(st * 2 + 1) * 64 + lane] = __builtin_bit_cast(u32x4, pack8<1>(xt));
        }
        float ssq[16];
#pragma unroll
        for (int i = 0; i < 16; ++i) ssq[i] = 0.f;
#pragma unroll 1
        for (int k = 0; k < 4; ++k) {
            const int H = g * 8 + hh * 4 + k;
            const float acs_l = sacs[k * 128 + l0 + r], Dk = dsk[H];
            const bf16_t* xrow0 = XST + ((size_t)b * 1024 + H * 64 + r) * S_ + pos0;
            f32x16 yd0 = zero16(), yd1 = zero16(), yo0 = zero16(), yo1 = zero16();
#pragma unroll 1
            for (int st = 0; st <= w; ++st) {
                const u32x4 x0 = xl[(st * 2 + 0) * 64 + lane], x1 = xl[(st * 2 + 1) * 64 + lane];
                f32x16 m;
#pragma unroll
                for (int i4 = 0; i4 < 4; ++i4) {
                    const f32x4 as4 = *(const f32x4*)(sacs + k * 128 + 32 * st + 8 * i4 + 4 * h);
                    const f32x4 dt4 = *(const f32x4*)(sdtv + k * 128 + 32 * st + 8 * i4 + 4 * h);
#pragma unroll
                    for (int j = 0; j < 4; ++j) {
                        const int sl = 8 * i4 + 4 * h + j;
                        const bool valid = (st < w) || (sl <= r);
                        const float e = valid ? __expf(acs_l - as4[j]) * dt4[j] : 0.f;
                        const unsigned xw = (i4 >> 1) ? x1[2 * (i4 & 1) + (j >> 1)] : x0[2 * (i4 & 1) + (j >> 1)];
                        m[4 * i4 + j] = ((j & 1) ? bfhi(xw) : bflo(xw)) * e;
                    }
                }
                const bf16x8 pa0 = pack8<0>(m), pa1 = pack8<1>(m);
                const bf16_t* xb0 = xrow0 + 32 * st + 4 * h;
                {
                    u32x4 f0, f1;
                    const u32x2 a0 = *(const u32x2*)(xb0), a1 = *(const u32x2*)(xb0 + 8), a2 = *(const u32x2*)(xb0 + 16), a3 = *(const u32x2*)(xb0 + 24);
                    f0.x = a0.x; f0.y = a0.y; f0.z = a1.x; f0.w = a1.y; f1.x = a2.x; f1.y = a2.y; f1.z = a3.x; f1.w = a3.y;
                    yd0 = mfma32(pa0, __builtin_bit_cast(bf16x8, f0), yd0);
                    yd0 = mfma32(pa1, __builtin_bit_cast(bf16x8, f1), yd0);
                }
                {
                    const bf16_t* xb1 = xb0 + (size_t)32 * S_;
                    u32x4 f0, f1;
                    const u32x2 a0 = *(const u32x2*)(xb1), a1 = *(const u32x2*)(xb1 + 8), a2 = *(const u32x2*)(xb1 + 16), a3 = *(const u32x2*)(xb1 + 24);
                    f0.x = a0.x; f0.y = a0.y; f0.z = a1.x; f0.w = a1.y; f1.x = a2.x; f1.y = a2.y; f1.z = a3.x; f1.w = a3.y;
                    yd1 = mfma32(pa0, __builtin_bit_cast(bf16x8, f0), yd1);
                    yd1 = mfma32(pa1, __builtin_bit_cast(bf16x8, f1), yd1);
                }
            }
            const bf16_t* prow = PREV + ((((size_t)b * 64 + c) * 16 + H) * 64 + r) * 128 + 8 * h;
#pragma unroll 2
            for (int kk = 0; kk < 8; ++kk) {
                const bf16x8 cf = *(const bf16x8*)(crow_p + 16 * kk);
                yo0 = mfma32(cf, *(const bf16x8*)(prow + 16 * kk), yo0);
                yo1 = mfma32(cf, *(const bf16x8*)(prow + 32 * 128 + 16 * kk), yo1);
            }
            {
                const int col = H * 64 + r;
                const float nw0 = nw[col], nw1 = nw[col + 32];
                const bf16_t* zp = Z + (size_t)(t0 + l0 + 4 * h) * 1024 + col;
                bf16_t* yp = YC + (size_t)(t0 + l0 + 4 * h) * 1536 + col;
                const bf16_t* xp = xrow0 + l0 + 4 * h;
                const float* eap = sacs + k * 128 + l0 + 4 * h;
#pragma unroll
                for (int i4 = 0; i4 < 4; ++i4) {
                    asm volatile("" : "+v"(zp), "+v"(yp), "+v"(xp));
                    const f32x4 ea = *(const f32x4*)(eap + 8 * i4);
                    typedef const __attribute__((address_space(1))) bf16_t* gcp; typedef __attribute__((address_space(1))) bf16_t* gwp;
                    typedef const __attribute__((address_space(1))) u32x2* gcp2;
                    const gcp zg = (gcp)(unsigned long long)zp; const gwp yg_ = (gwp)(unsigned long long)yp;
                    const u32x2 xa = *(gcp2)(unsigned long long)(xp), xb = *(gcp2)(unsigned long long)(xp + (size_t)32 * S_);
#pragma unroll
                    for (int j = 0; j < 4; ++j) {
                        const int i = 4 * i4 + j;
                        const float ee = __expf(ea[j]);
                        const float xs0 = j == 0 ? bflo(xa.x) : (j == 1 ? bfhi(xa.x) : (j == 2 ? bflo(xa.y) : bfhi(xa.y)));
                        const float xs1 = j == 0 ? bflo(xb.x) : (j == 1 ? bfhi(xb.x) : (j == 2 ? bflo(xb.y) : bfhi(xb.y)));
                        const float y0 = yd0[i] + ee * yo0[i] + Dk * xs0, y1 = yd1[i] + ee * yo1[i] + Dk * xs1;
                        const float g0 = y0 * silu_f(bf2f(zg[j * 1024])), g1 = y1 * silu_f(bf2f(zg[j * 1024 + 32]));
                        ssq[i] += g0 * g0 + g1 * g1;
                        yg_[j * 1536] = f2bf(g0 * nw0); yg_[j * 1536 + 32] = f2bf(g1 * nw1);
                    }
                    zp += 8 * 1024; yp += 8 * 1536; xp += 8;
                }
            }
        }
#pragma unroll
        for (int i = 0; i < 16; ++i) {
            float s = ssq[i];
            s += __shfl_xor(s, 1); s += __shfl_xor(s, 2); s += __shfl_xor(s, 4); s += __shfl_xor(s, 8); s += __shfl_xor(s, 16);
            if (r == 0) atomicAdd(SSQ + t0 + l0 + crow(i, h), s);
        }
        __syncthreads();
    }
}

DI void phase_even_out(const Ctx& cx, const P& p, unsigned char* smem, int layer) {
    const float* SSQ = (const float*)(p.ws + OFF_MISC + MISC_SSQ) + (size_t)layer * 2 * T_;
    auto hook = [=](auto& acc, int mb, int lane) {
        const int h = lane >> 5;
#pragma unroll
        for (int mt = 0; mt < 2; ++mt)
#pragma unroll
            for (int i4 = 0; i4 < 4; ++i4) {
                unsigned ri = (unsigned)(mb + 32 * mt + 8 * i4 + 4 * h);
                asm volatile("" : "+v"(ri));
                const f32x4 q4 = *(const f32x4*)(SSQ + ri);
#pragma unroll
                for (int j = 0; j < 4; ++j) {
                    const float rs = 1.0f / sqrtf(q4[j] * (1.f / 1024.f) + 1e-6f);
#pragma unroll
                    for (int nt = 0; nt < (int)(sizeof(acc[0]) / sizeof(f32x16)); ++nt) acc[mt][nt][4 * i4 + j] *= rs;
                }
            }
    };
    const EpiResidLN epi = make_ln_epi(cx, p, smem, layer, 0);
    gemm_phase<true, false>(cx, smem, (const bf16_t*)(p.ws + OFF_R + RE_XBC), 1536, (const bf16_t*)(p.ws + OFF_WM) + WE_OUT, 1536, 1536, T_, 1024, epi, hook, 15);
}

DI void phase_odd_in(const Ctx& cx, const P& p, unsigned char* smem, int layer) {
    unsigned char* R = p.ws + OFF_R;
    bf16_t* QF = (bf16_t*)(R + RO_QF); bf16_t* KF = (bf16_t*)(R + RO_KF); bf16_t* VF = (bf16_t*)(R + RO_VF); bf16_t* CQ = (bf16_t*)(R + RO_CQ);
    bf16_t* CKV = (bf16_t*)(R + RO_CKV); bf16_t* KR = (bf16_t*)(R + RO_KR); float* FL = (float*)(R + RO_FL);
    float* SSQ = (float*)(p.ws + OFF_MISC + MISC_SSQ) + (size_t)layer * 2 * T_;
    const f32x2* rope = (const f32x2*)(p.ws + OFF_MISC + MISC_ROPE);
    auto tile = [=](const f32x16& a0, const f32x16& a1, int mb, int cb, int lane) {
        const int h = lane >> 5, c = lane & 31, col = cb + c;
#pragma unroll
        for (int mt = 0; mt < 2; ++mt)
#pragma unroll
            for (int i4 = 0; i4 < 4; ++i4) {
                int rb = mb + 32 * mt + 8 * i4 + 4 * h;
                asm volatile("" : "+v"(rb));
#pragma unroll
                for (int j = 0; j < 4; ++j) {
                    const int row = rb + j;
                    const float v = mt == 0 ? a0[4 * i4 + j] : a1[4 * i4 + j];
                    if (cb < 1536) {
                        bf16_t* dst = QF + (size_t)(cb >> 9) * (8u << 20);
                        dst[(size_t)row * 512 + (col & 511)] = f2bf(cb < 512 ? v * QS_FOX : v);
                    } else if (cb < 2304) {
                        const bool isq = cb < 2048;
                        if (isq) CQ[(size_t)row * 512 + col - 1536] = f2bf(v); else CKV[(size_t)row * 256 + col - 2048] = f2bf(v);
                        float s = v * v;
                        s += __shfl_xor(s, 1); s += __shfl_xor(s, 2); s += __shfl_xor(s, 4); s += __shfl_xor(s, 8); s += __shfl_xor(s, 16);
                        if (c == 0) atomicAdd(SSQ + (isq ? 0 : T_) + row, s);
                    } else if (cb == 2304) {
                        const float o = __shfl_xor(v, 16);
                        const f32x2 cs = rope[(size_t)(row & (S_ - 1)) * 16 + (c & 15)];
                        KR[(size_t)row * 32 + c] = f2bf((c < 16) ? (v * cs.x - o * cs.y) : (v * cs.x + o * cs.y));
                    } else if (cb == 2336) {
                        if (c < 8) FL[(size_t)row * 8 + c] = v;
                    }
                }
            }
    };
    auto epi = [=](auto& acc, int mb, int nb, int lane) {
#pragma unroll
        for (int nt = 0; nt < (int)(sizeof(acc[0]) / sizeof(f32x16)); ++nt) tile(acc[0][nt], acc[1][nt], mb, nb + 32 * nt, lane);
    };
    gemm_phase<false, true, true, true>(cx, smem, (const bf16_t*)(p.ws + OFF_XB), 1024, (const bf16_t*)(p.ws + OFF_WM) + WO_IN, 1024, 1024, T_, 2432, epi, NoHook(), -1);
}

DI float logsig(float x) { return fminf(x, 0.f) - log1pf(expf(-fabsf(x))); }

DI void phase_odd_qkv(const Ctx& cx, const P& p, unsigned char* smem, int li, int layer) {
    unsigned char* R = p.ws + OFF_R;
    const bf16_t* CQ = (const bf16_t*)(R + RO_CQ); const bf16_t* CKV = (const bf16_t*)(R + RO_CKV);
    bf16_t* QM = (bf16_t*)(R + RO_QM); bf16_t* KN = (bf16_t*)(R + RO_KN); bf16_t* VM = (bf16_t*)(R + RO_VM);
    const float* FL = (const float*)(R + RO_FL); float* FC = (float*)(R + RO_FC);
    const float* SSQ = (const float*)(p.ws + OFF_MISC + MISC_SSQ) + (size_t)layer * 2 * T_;
    const f32x2* rope = (const f32x2*)(p.ws + OFF_MISC + MISC_ROPE);
    const bf16_t* wm = (const bf16_t*)(p.ws + OFF_WM);
    if (cx.bid >= cx.nb - 16) {
        const float* fb = p.fgate_b + li * 8;
        double* sd = (double*)smem;
        const int tid = cx.tid, u = cx.bid - (cx.nb - 16);
        const int b = u >> 3, hd = u & 7;
        const float bias = fb[hd];
        float loc = 0.f;
        for (int j = 0; j < 32; ++j) loc += logsig(FL[(size_t)(b * S_ + tid * 32 + j) * 8 + hd] + bias);
        sd[tid] = (double)loc;
        __syncthreads();
        double base = 0.0;
        for (int j = 0; j < tid; ++j) base += sd[j];
        float run = 0.f;
        for (int j = 0; j < 32; ++j) {
            run += logsig(FL[(size_t)(b * S_ + tid * 32 + j) * 8 + hd] + bias);
            FC[((size_t)b * 8 + hd) * S_ + tid * 32 + j] = (float)((base + (double)run) * (double)LOG2E);
        }
        __syncthreads();
    }
    auto epiq = [=](auto& acc, int mb, int nb, int lane) {
        constexpr int NT = sizeof(acc[0]) / sizeof(f32x16);
        const int h = lane >> 5, c = lane & 31;
#pragma unroll
        for (int mt = 0; mt < 2; ++mt)
#pragma unroll
            for (int i4 = 0; i4 < 4; ++i4) {
                int rb = mb + 32 * mt + 8 * i4 + 4 * h;
                asm volatile("" : "+v"(rb));
#pragma unroll
                for (int j = 0; j < 4; ++j) {
                    const int row = rb + j;
                    const float rs = 1.0f / sqrtf(SSQ[row] * (1.f / 512.f) + 1e-6f);
                    const f32x2 cs = rope[(size_t)(row & (S_ - 1)) * 16 + (c & 15)];
#pragma unroll
                    for (int nt = 0; nt < NT; ++nt) {
                        const int cb = nb + 32 * nt;
                        float v = acc[mt][nt][4 * i4 + j] * rs;
                        if ((cb % 96) >= 64) {
                            const float o = __shfl_xor(v, 16);
                            v = (c < 16) ? (v * cs.x - o * cs.y) : (v * cs.x + o * cs.y);
                        }
                        QM[(size_t)row * 768 + cb + c] = f2bf(v * QS_MLA);
                    }
                }
            }
    };
    gemm_phase<false, false, false>(cx, smem, CQ, 512, wm + WO_UQ, 512, 512, T_, 768, epiq, NoHook(), -1);
    auto epikv = [=](auto& acc, int mb, int nb, int lane) {
        epi_each(acc, mb, nb, lane, [=](int row, int col, float v) {
            const float rs = 1.0f / sqrtf(SSQ[T_ + row] * (1.f / 256.f) + 1e-6f);
            const int hd = col >> 7, j = col & 127;
            if (j < 64) KN[(size_t)row * 512 + hd * 64 + j] = f2bf(v * rs); else VM[(size_t)row * 512 + hd * 64 + j - 64] = f2bf(v * rs);
        });
    };
    gemm_phase<false, false, false>(cx, smem, CKV, 256, wm + WO_UKV, 256, 256, T_, 1024, epikv, NoHook(), -1);
    {
        const bf16_t* QF = (const bf16_t*)(R + RO_QF); const bf16_t* KF = (const bf16_t*)(R + RO_KF);
        unsigned* NRM = (unsigned*)(p.ws + OFF_MISC + MISC_NRM) + layer * 32;
        for (int idx = cx.bid * 256 + cx.tid; idx < T_ * 8; idx += cx.nb * 256) {
            const int row = idx >> 3, hd = idx & 7, b = row >> 13;
            float sq = 0.f, sk = 0.f;
#pragma unroll
            for (int j = 0; j < 8; ++j) {
                const u32x4 a = *(const u32x4*)(QF + (size_t)row * 512 + hd * 64 + 8 * j), c = *(const u32x4*)(KF + (size_t)row * 512 + hd * 64 + 8 * j);
#pragma unroll
                for (int e = 0; e < 4; ++e) { const float a0 = bflo(a[e]), a1 = bfhi(a[e]), c0 = bflo(c[e]), c1 = bfhi(c[e]); sq += a0 * a0 + a1 * a1; sk += c0 * c0 + c1 * c1; }
            }
            sq = fmaxf(sq, __shfl_xor(sq, 8)); sq = fmaxf(sq, __shfl_xor(sq, 16)); sq = fmaxf(sq, __shfl_xor(sq, 32));
            sk = fmaxf(sk, __shfl_xor(sk, 8)); sk = fmaxf(sk, __shfl_xor(sk, 16)); sk = fmaxf(sk, __shfl_xor(sk, 32));
            if ((cx.tid & 63) < 8) { atomicMax(NRM + (b * 8 + hd) * 2, __float_as_uint(sq)); atomicMax(NRM + (b * 8 + hd) * 2 + 1, __float_as_uint(sk)); }
        }
    }
}

DI void phase_attn(const Ctx& cx, const P& p, unsigned char* smem, int cidx) {
    unsigned char* R = p.ws + OFF_R;
    const bf16_t* QF = (const bf16_t*)(R + RO_QF); const bf16_t* KF = (const bf16_t*)(R + RO_KF); const bf16_t* VF = (const bf16_t*)(R + RO_VF);
    const bf16_t* QM = (const bf16_t*)(R + RO_QM); const bf16_t* KN = (const bf16_t*)(R + RO_KN); const bf16_t* VM = (const bf16_t*)(R + RO_VM);
    const bf16_t* KR = (const bf16_t*)(R + RO_KR); const float* FC = (const float*)(R + RO_FC); bf16_t* OC = (bf16_t*)(R + RO_OCAT);
    int* cnt = (int*)(p.ws + OFF_MISC + MISC_CNT) + cidx;
    const int tid = cx.tid, lane = tid & 63, w = __builtin_amdgcn_readfirstlane(tid >> 6), r = lane & 31, h = lane >> 5;
    constexpr int KST = 104, VST = 96;
    constexpr int STAGE = 64 * KST * 2 + 64 * VST * 2 + 256;
    int* s_unit = (int*)(smem + 2 * STAGE);
    int* s_kt0 = s_unit + 1;
    const unsigned* NRM = (const unsigned*)(p.ws + OFF_MISC + MISC_NRM) + (cidx & 3) * 32;
    for (;;) {
        if (tid == 0) *s_unit = atomicAdd(cnt, 1);
        __syncthreads();
        const int u = *s_unit;
        __syncthreads();
        if (u >= 2048) break;
        const int qb = 63 - (u >> 5), rr = u & 31, kind = rr >> 4, b = (rr >> 3) & 1, hd = rr & 7;
        const bool fox = kind == 1;
        const int q0 = qb * 128, qrow0 = q0 + 32 * w, nkt = 2 * qb + 2;
        const size_t tb = (size_t)b * S_;
        const bf16_t* Kb = fox ? KF : KN; const bf16_t* Vb = fox ? VF : VM;
        const int cpr = fox ? 8 : 12, npiece = 64 * cpr;
        bf16x8 qf[6];
#pragma unroll
        for (int k = 0; k < 6; ++k) {
            if (fox) { if (k < 4) qf[k] = *(const bf16x8*)(QF + (tb + qrow0 + r) * 512 + hd * 64 + 16 * k + 8 * h); else qf[k] = (bf16x8){0, 0, 0, 0, 0, 0, 0, 0}; }
            else qf[k] = *(const bf16x8*)(QM + (tb + qrow0 + r) * 768 + hd * 96 + 16 * k + 8 * h);
        }
        int kt0 = 0;
        if (fox) {
            const float bnd = sqrtf(__uint_as_float(NRM[(b * 8 + hd) * 2]) * __uint_as_float(NRM[(b * 8 + hd) * 2 + 1])) * 1.01f;
            const float thr = -(2.f * bnd + 40.f);
            const float* fc = FC + ((size_t)b * 8 + hd) * S_;
            const float fq0 = fc[q0];
            if (tid == 0) *s_kt0 = nkt - 1;
            __syncthreads();
            if (tid < nkt) { if (!(fq0 - fc[tid * 64 + 63] < thr)) atomicMin(s_kt0, tid); }
            __syncthreads();
            kt0 = *s_kt0;
        }
        f32x16 O[2] = {zero16(), zero16()};
        float mrun = -INFINITY, lsum = 0.f;
        u32x4 rk[3], rv[2]; float rfk = 0.f;
        auto gload = [&](int kt) {
            const size_t kbase = tb + (size_t)kt * 64;
#pragma unroll
            for (int i = 0; i < 3; ++i) {
                const int pc = tid + 256 * i;
                if (pc < npiece) {
                    const int row = pc / cpr, ch = pc - row * cpr;
                    rk[i] = ch < 8 ? *(const u32x4*)(Kb + (kbase + row) * 512 + hd * 64 + ch * 8) : *(const u32x4*)(KR + (kbase + row) * 32 + (ch - 8) * 8);
                }
            }
#pragma unroll
            for (int i = 0; i < 2; ++i) { const int pc = tid + 256 * i, row = pc >> 3, ch = pc & 7; rv[i] = *(const u32x4*)(Vb + (kbase + row) * 512 + hd * 64 + ch * 8); }
            if (fox && tid < 64) rfk = FC[((size_t)b * 8 + hd) * S_ + kt * 64 + tid];
        };
        auto lstore = [&](int st) {
            bf16_t* Ks = (bf16_t*)(smem + st * STAGE); bf16_t* Vs = Ks + 64 * KST; float* fks = (float*)(Vs + 64 * VST);
#pragma unroll
            for (int i = 0; i < 3; ++i) { const int pc = tid + 256 * i; if (pc < npiece) { const int row = pc / cpr, ch = pc - row * cpr; *(u32x4*)(Ks + row * KST + ch * 8) = rk[i]; } }
#pragma unroll
            for (int i = 0; i < 2; ++i) { const int pc = tid + 256 * i, row = pc >> 3, ch = pc & 7; *(u32x4*)(Vs + row * VST + ch * 8) = rv[i]; }
            if (fox && tid < 64) fks[tid] = rfk;
        };
        auto compute = [&](auto foxc, const bf16_t* Ks, const bf16_t* Vs, const float* fks, int kt) {
            constexpr bool FOX = decltype(foxc)::value;
            constexpr int NK = FOX ? 4 : 6;
            f32x16 s[2] = {zero16(), zero16()};
            {
                const bf16_t* kb = Ks + r * KST + 8 * h;
                bf16x8 kc = *(const bf16x8*)(kb);
#pragma unroll
                for (int step = 0; step < 2 * NK; ++step) {
                    bf16x8 kn = kc;
                    if (step + 1 < 2 * NK) kn = *(const bf16x8*)(kb + ((step + 1) / NK) * 32 * KST + ((step + 1) % NK) * 16);
                    __builtin_amdgcn_sched_barrier(0);
                    s[step / NK] = mfma32(kc, qf[step % NK], s[step / NK]);
                    kc = kn;
                }
            }
            const int q4 = (lane & 15) >> 2, p4 = lane & 3, blk = (lane >> 4) & 1;
            const bf16_t* vbase = Vs + (4 * h + q4) * VST + 16 * blk + 4 * p4;
            auto ldv = [&](int idx) -> bf16x8 {
                const bf16_t* va = vbase + (32 * (idx >> 2) + 16 * (idx & 1)) * VST + 32 * ((idx >> 1) & 1);
                const s16x4 lo = __builtin_amdgcn_ds_read_tr16_b64_v4i16((__attribute__((address_space(3))) s16x4*)(va));
                const s16x4 hi = __builtin_amdgcn_ds_read_tr16_b64_v4i16((__attribute__((address_space(3))) s16x4*)(va + 8 * VST));
                return __builtin_shufflevector(lo, hi, 0, 1, 2, 3, 4, 5, 6, 7);
            };
            if (FOX) {
#pragma unroll
                for (int st = 0; st < 2; ++st)
#pragma unroll
                    for (int i4 = 0; i4 < 4; ++i4) {
                        const f32x4 fk4 = *(const f32x4*)(fks + 32 * st + 8 * i4 + 4 * h);
#pragma unroll
                        for (int j = 0; j < 4; ++j) s[st][4 * i4 + j] -= fk4[j];
                    }
            }
            if (kt * 64 + 63 > qrow0) {
                asm volatile("" ::: "memory");
                const int qpos = qrow0 + r;
#pragma unroll
                for (int st = 0; st < 2; ++st)
#pragma unroll
                    for (int i = 0; i < 16; ++i) { const int key = kt * 64 + 32 * st + crow(i, h); if (key > qpos) s[st][i] = -INFINITY; }
            }
            float mx = -INFINITY;
#pragma unroll
            for (int st = 0; st < 2; ++st)
#pragma unroll
                for (int i = 0; i < 16; ++i) mx = fmaxf(mx, s[st][i]);
            mx = fmaxf(mx, __shfl_xor(mx, 32));
            const float mnew = fmaxf(mrun, mx);
            if (__builtin_amdgcn_ballot_w64(mnew > mrun)) {
                const float alpha = __builtin_amdgcn_exp2f(mrun - mnew);
                lsum *= alpha;
#pragma unroll
                for (int dt = 0; dt < 2; ++dt)
#pragma unroll
                    for (int i = 0; i < 16; ++i) O[dt][i] *= alpha;
                mrun = mnew;
            }
            float ps = 0.f;
#pragma unroll
            for (int st = 0; st < 2; ++st)
#pragma unroll
                for (int i = 0; i < 16; ++i) { const float pv = __builtin_amdgcn_exp2f(s[st][i] - mnew); s[st][i] = pv; ps += pv; }
            lsum += ps;
            const bf16x8 pb[4] = {pack8<0>(s[0]), pack8<1>(s[0]), pack8<0>(s[1]), pack8<1>(s[1])};
            bf16x8 vc = ldv(0);
#pragma unroll
            for (int idx = 0; idx < 8; ++idx) {
                bf16x8 vn = vc;
                if (idx + 1 < 8) vn = ldv(idx + 1);
                __builtin_amdgcn_sched_barrier(0);
                O[(idx >> 1) & 1] = mfma32(vc, pb[(idx >> 2) * 2 + (idx & 1)], O[(idx >> 1) & 1]);
                vc = vn;
            }
        };
        gload(kt0); lstore(0);
        __syncthreads();
        for (int kt = kt0; kt < nkt; ++kt) {
            const int cur = (kt - kt0) & 1;
            if (kt + 1 < nkt) gload(kt + 1);
            if (kt * 64 <= qrow0 + 31) {
                const bf16_t* Ks = (const bf16_t*)(smem + cur * STAGE); const bf16_t* Vs = Ks + 64 * KST; const float* fks = (const float*)(Vs + 64 * VST);
                if (fox) compute(std::integral_constant<bool, true>(), Ks, Vs, fks, kt);
                else compute(std::integral_constant<bool, false>(), Ks, Vs, fks, kt);
            }
            if (kt + 1 < nkt) lstore(cur ^ 1);
            __syncthreads();
        }
        const float lt = lsum + __shfl_xor(lsum, 32);
        const float inv = 1.0f / lt;
        bf16_t* orow = OC + (tb + qrow0 + r) * 1024 + (fox ? 0 : 512) + hd * 64;
#pragma unroll
        for (int dt = 0; dt < 2; ++dt)
#pragma unroll
            for (int i4 = 0; i4 < 4; ++i4) {
                u32x2 o; o.x = pk2(O[dt][4 * i4] * inv, O[dt][4 * i4 + 1] * inv); o.y = pk2(O[dt][4 * i4 + 2] * inv, O[dt][4 * i4 + 3] * inv);
                *(u32x2*)(orow + 32 * dt + 8 * i4 + 4 * h) = o;
            }
    }
}

DI void phase_odd_out(const Ctx& cx, const P& p, unsigned char* smem, int layer) {
    const EpiResidLN epi = make_ln_epi(cx, p, smem, layer, 0);
    gemm_phase<false, false>(cx, smem, (const bf16_t*)(p.ws + OFF_R + RO_OCAT), 1024, (const bf16_t*)(p.ws + OFF_WM) + WO_OUT, 1024, 1024, T_, 1024, epi, NoHook(), -1);
}

constexpr int N_PHASES = 29;
DI void run_phase(const Ctx& cx, const P& p_in, int ph, unsigned char* smem) {
    P p = p_in;
    { unsigned long long* q_ = (unsigned long long*)&p;
#pragma unroll
      for (int i_ = 0; i_ < 27; ++i_) asm volatile("" : "+s"(q_[i_])); }
#define AS_GLOBAL(m) p.m = (decltype(p.m))(__attribute__((address_space(1))) unsigned char*)(unsigned long long)p.m
    AS_GLOBAL(x); AS_GLOBAL(even_w_in); AS_GLOBAL(pool_w); AS_GLOBAL(pool_scale); AS_GLOBAL(conv_w); AS_GLOBAL(conv_b); AS_GLOBAL(dt_bias); AS_GLOBAL(a_log);
    AS_GLOBAL(d_skip); AS_GLOBAL(ssm_norm_w); AS_GLOBAL(even_w_out); AS_GLOBAL(odd_w_in); AS_GLOBAL(fgate_b); AS_GLOBAL(q_norm_w); AS_GLOBAL(w_uq); AS_GLOBAL(kv_norm_w);
    AS_GLOBAL(w_ukv); AS_GLOBAL(odd_w_out); AS_GLOBAL(ffn_w_gate); AS_GLOBAL(ffn_w_up); AS_GLOBAL(ffn_w_down); AS_GLOBAL(ln_mix_g); AS_GLOBAL(ln_mix_b); AS_GLOBAL(ln_ffn_g);
    AS_GLOBAL(ln_ffn_b); AS_GLOBAL(out); AS_GLOBAL(ws);
#undef AS_GLOBAL
    if (ph == 0) { phase_prep(cx, p, smem); return; }
    int q = ph - 1, layer;
    if (q < 8) layer = 0; else if (q < 14) { layer = 1; q -= 8; } else if (q < 22) { layer = 2; q -= 14; } else { layer = 3; q -= 22; }
    const int li = layer >> 1;
    if ((layer & 1) == 0) {
        switch (q) {
            case 0: phase_even_in(cx, p, smem); convert_ffn_weights(cx, p, smem, layer); break;
            case 1: phase_even_conv(cx, p, smem, li); break;
            case 2: phase_even_states(cx, p, smem, li); break;
            case 3: phase_even_scan(cx, p); break;
            case 4: phase_even_y(cx, p, smem, li, layer); break;
            case 5: phase_even_out(cx, p, smem, layer); break;
            case 6: phase_ffn1(cx, p, smem); convert_mixer_weights(cx, p, smem, layer + 1); break;
            default: phase_ffn2(cx, p, smem, layer); break;
        }
    } else {
        switch (q) {
            case 0: phase_odd_in(cx, p, smem, layer); convert_ffn_weights(cx, p, smem, layer); break;
            case 1: phase_odd_qkv(cx, p, smem, li, layer); break;
            case 2: phase_attn(cx, p, smem, layer); break;
            case 3: phase_odd_out(cx, p, smem, layer); break;
            case 4: phase_ffn1(cx, p, smem); if (layer + 1 < 4) convert_mixer_weights(cx, p, smem, layer + 1); break;
            default: phase_ffn2(cx, p, smem, layer); break;
        }
    }
}

#define XB_TMO      128
#define XB_XCNT(j)  (256  + 64 * (j))
#define XB_XSUB(j)  (1280 + 64 * (j))
#define XB_XGEN(j)  (2304 + 64 * (j))
#define XB_TOP      3328
#define XB_TOPGEN   3392
#define XCD_BAR_WORDS 3456
#define XB_SPIN_CAP (1u << 20)
#define LAS __attribute__((address_space(3)))
DI unsigned xb_ld(unsigned* p) { return __hip_atomic_load(p, __ATOMIC_RELAXED, __HIP_MEMORY_SCOPE_AGENT); }
DI unsigned xb_add(unsigned* p, unsigned v) { return __hip_atomic_fetch_add(p, v, __ATOMIC_RELAXED, __HIP_MEMORY_SCOPE_AGENT); }
DI unsigned xb_xcc_id() { return (unsigned)__builtin_amdgcn_s_getreg((3 << 11) | 20) & 0xFu; }
#define XB_SPIN(cond, bar) do { unsigned _sp = 0; while (cond) { __builtin_amdgcn_s_sleep(1); \
    if ((++_sp & 255u) == 0u) { if (xb_ld(&(bar)[XB_TMO])) break; if (_sp > XB_SPIN_CAP) { atomicAdd(&(bar)[XB_TMO], 1u); break; } } } } while (0)
struct XcdBarrier { unsigned* bar; unsigned x; volatile LAS unsigned* st; };
DI XcdBarrier xcd_barrier_post(unsigned* bar, volatile LAS unsigned* st) {
    XcdBarrier b; b.bar = bar; b.x = xb_xcc_id(); b.st = st;
    if (threadIdx.x == 0) (void)xb_add(&bar[XB_XCNT(b.x)], 1u);
    return b;
}
DI void xcd_barrier_complete(unsigned* bar, unsigned x, unsigned& nloc, unsigned& nx) {
    const unsigned G = gridDim.x;
    unsigned sum, cnt, mine, sp = 0u;
    for (;;) {
        sum = 0u; cnt = 0u; mine = 0u;
#pragma unroll
        for (unsigned j = 0; j < 16; ++j) { const unsigned c = xb_ld(&bar[XB_XCNT(j)]); sum += c; cnt += (c > 0u) ? 1u : 0u; mine = (j == x) ? c : mine; }
        if (sum == G) break;
        __builtin_amdgcn_s_sleep(1);
        if ((++sp & 255u) == 0u) { if (xb_ld(&bar[XB_TMO])) break; if (sp > XB_SPIN_CAP) { atomicAdd(&bar[XB_TMO], 1u); break; } }
    }
    nloc = mine > 0u ? mine : 1u; nx = cnt > 0u ? cnt : 1u;
}
DI void xcd_barrier(const XcdBarrier& b) {
    asm volatile("s_waitcnt vmcnt(0)" ::: "memory");
    __syncthreads();
    if (threadIdx.x == 0) {
        unsigned* bar = b.bar;
        __builtin_amdgcn_s_waitcnt(0);
        unsigned nloc = b.st[0], nx = b.st[1];
        if (nloc == 0u) { xcd_barrier_complete(bar, b.x, nloc, nx); b.st[0] = nloc; b.st[1] = nx; }
        const unsigned old = xb_add(&bar[XB_XSUB(b.x)], 1u);
        const unsigned gen = old / nloc;
        if (old + 1u == (gen + 1u) * nloc) {
            __builtin_amdgcn_fence(__ATOMIC_RELEASE, "agent");
            asm volatile("s_waitcnt vmcnt(0)" ::: "memory");
            const unsigned og = xb_add(&bar[XB_TOP], 1u);
            const unsigned tg = og / nx;
            if (og + 1u == (tg + 1u) * nx) xb_add(&bar[XB_TOPGEN], 1u);
            else XB_SPIN(xb_ld(&bar[XB_TOPGEN]) == tg, bar);
            __builtin_amdgcn_fence(__ATOMIC_ACQUIRE, "agent");
            xb_add(&bar[XB_XGEN(b.x)], 1u);
            asm volatile("s_waitcnt vmcnt(0)" ::: "memory");
        } else {
            XB_SPIN(xb_ld(&bar[XB_XGEN(b.x)]) == gen, bar);
            __builtin_amdgcn_fence(__ATOMIC_ACQUIRE, "agent");
            asm volatile("s_waitcnt vmcnt(0)" ::: "memory");
        }
    }
    __syncthreads();
}
constexpr size_t MISC_BAR = 2 * MB;

__global__ void __launch_bounds__(256, 2) mega(P p) {
    extern __shared__ __attribute__((aligned(16))) unsigned char smem[];
    cg::grid_group grid = cg::this_grid();
    const int lo = (int)p.ph_lo, hi = (int)p.ph_hi;
    const int widx = __builtin_amdgcn_readfirstlane((int)(threadIdx.x >> 6));
    if (hi < 0) grid.sync();
    volatile LAS unsigned* xbw = (volatile LAS unsigned*)(smem + 73728);
    if (threadIdx.x == 0) { xbw[0] = 0u; xbw[1] = 0u; xbw[2] = 0u; xbw[3] = 0u; }
    __syncthreads();
    const XcdBarrier xb = xcd_barrier_post((unsigned*)(p.ws + OFF_MISC + MISC_BAR), xbw);
    for (int ph = lo; ph < hi; ++ph) {
        unsigned allm = ~0u; asm volatile("" : "+s"(allm));
        Ctx cx; cx.tid = widx * 64 + (int)__builtin_amdgcn_mbcnt_hi(allm, __builtin_amdgcn_mbcnt_lo(allm, 0u)); cx.bid = blockIdx.x; cx.nb = gridDim.x;
        asm volatile("" : "+v"(cx.tid)); asm volatile("" : "+s"(cx.bid)); asm volatile("" : "+s"(cx.nb));
#ifdef ONLY_PHASE
        run_phase(cx, p, ONLY_PHASE, smem);
#else
        run_phase(cx, p, ph, smem);
#endif
        if (ph + 1 < hi) { xcd_barrier(xb); if (PROBE_DUP == 3) xcd_barrier(xb); }
    }
}

extern "C" void kernel_launch(void* const* d_in, const int* in_sizes, int n_in, void* d_out, int out_size, void* d_ws, size_t ws_size, hipStream_t stream) {
    static int grid_blocks = 0;
    if (grid_blocks == 0) {
        int dev = 0, cus = 0, per_cu = 0;
        hipGetDevice(&dev);
        hipDeviceGetAttribute(&cus, hipDeviceAttributeMultiprocessorCount, dev);
        hipFuncSetAttribute((const void*)mega, hipFuncAttributeMaxDynamicSharedMemorySize, SMEM_BYTES);
        hipOccupancyMaxActiveBlocksPerMultiprocessor(&per_cu, (const void*)mega, 256, SMEM_BYTES);
        if (per_cu < 1) per_cu = 1;
        if (per_cu > 2) per_cu = 2;
        grid_blocks = (cus * per_cu) & ~7;
        if (ws_size < WS_NEED || n_in != 25) { fprintf(stderr, "kernel_launch: unexpected ws_size %zu / n_in %d\n", ws_size, n_in); }
        fprintf(stderr, "kernel_launch: grid %d (cus %d x %d)\n", grid_blocks, cus, per_cu);
    }
    (void)hipMemsetAsync((unsigned char*)d_ws + OFF_MISC + MISC_BAR, 0, 32768, stream);
    P p{};
    const float** pp = (const float**)&p;
    for (int i = 0; i < 25; ++i) pp[i] = (const float*)d_in[i];
    p.out = (float*)d_out; p.ws = (unsigned char*)d_ws;
#if N_LAUNCH_MODE == 1
    p.ph_lo = 0; p.ph_hi = N_PHASES;
    void* args[] = {&p};
    hipError_t e = hipLaunchCooperativeKernel((const void*)mega, dim3(grid_blocks), dim3(256), args, SMEM_BYTES, stream);
    if (e != hipSuccess) fprintf(stderr, "cooperative launch failed: %s (grid %d)\n", hipGetErrorString(e), grid_blocks);
#else
    for (int ph = 0; ph < N_PHASES; ++ph) {
        p.ph_lo = ph; p.ph_hi = ph + 1;
        hipLaunchKernelGGL(mega, dim3(grid_blocks), dim3(256), SMEM_BYTES, stream, p);
    }
#endif
}
```
